# Optimizing an MI355X kernel written in HIP

```python
import math
import jax, jax.numpy as jnp
from jax import lax
import numpy as np

D_MODEL = 1024
BATCH = 4
SEQ = 8192
DEPTH = 1

D_MIX = D_MODEL
ATTN_HEADS = 4
ATTN_QK_DIM = 64
ATTN_V_DIM = 2 * ATTN_QK_DIM
ATTN_WIDTH = ATTN_HEADS * ATTN_V_DIM
ATTN_QK_WIDTH = 2 * ATTN_HEADS * ATTN_QK_DIM
RNN_WIDTH = D_MIX - ATTN_WIDTH
RNN_BLOCKS = 8
RNN_BLOCK_W = RNN_WIDTH // RNN_BLOCKS
CONV_WIDTH = 4
RG_LRU_C = 8.0
D_FF = 2816
N_BUCKETS = 32
MAX_DISTANCE = 128
Q_BLOCK = 128
NORM_EPS = 1e-6
N_MOD = 9
IN_SPLITS = (ATTN_QK_WIDTH, 2 * ATTN_QK_WIDTH, 2 * ATTN_QK_WIDTH + ATTN_WIDTH,
             2 * ATTN_QK_WIDTH + ATTN_WIDTH + RNN_WIDTH)
D_IN = 2 * ATTN_QK_WIDTH + ATTN_WIDTH + 2 * RNN_WIDTH

kernel_name = "hymba_style_diffattn_rglru_macaron_adaln"


def rms_norm(x, g):
    xf = x.astype(jnp.float32)
    y = xf * lax.rsqrt(jnp.mean(xf * xf, axis=-1, keepdims=True) + NORM_EPS)
    return (y * g.astype(jnp.float32)).astype(x.dtype)


def modulate(h, shift, scale):
    return h * (1 + scale[:, None, :]) + shift[:, None, :]


def swiglu(h, w1, w3, w2):
    return jnp.einsum('bsf,fd->bsd', jax.nn.silu(h @ w1) * (h @ w3), w2)


def t5_bucket(rel):
    n = jnp.maximum(rel, 0)
    max_exact = N_BUCKETS // 2
    nf = jnp.maximum(n, 1).astype(jnp.float32)
    large = max_exact + (jnp.log(nf / max_exact) / math.log(MAX_DISTANCE / max_exact)
                         * (N_BUCKETS - max_exact)).astype(jnp.int32)
    large = jnp.minimum(large, N_BUCKETS - 1)
    return jnp.where(n < max_exact, n, large)


def diff_attention(q, k, v, rel_bias, lam):
    B, _, S, _ = q.shape
    scale = ATTN_QK_DIM ** -0.5
    kpos = jnp.arange(S, dtype=jnp.int32)

    def block(start):
        qb = lax.dynamic_slice_in_dim(q, start, Q_BLOCK, axis=2)
        s = jnp.einsum('bmqd,bmkd->bmqk', qb, k,
                       preferred_element_type=jnp.float32) * scale
        rel = (start + jnp.arange(Q_BLOCK, dtype=jnp.int32))[:, None] - kpos[None, :]
        bias = jnp.take(rel_bias, t5_bucket(rel), axis=0)
        s = s + jnp.transpose(bias, (2, 0, 1)).astype(jnp.float32)[None]
        s = jnp.where((rel >= 0)[None, None], s, -jnp.inf)
        p = jax.nn.softmax(s, axis=-1).reshape(B, ATTN_HEADS, 2, Q_BLOCK, S)
        a = p[:, :, 0] - lam * p[:, :, 1]
        return jnp.einsum('bhqk,bhkv->bhqv', a.astype(v.dtype), v)

    starts = jnp.arange(S // Q_BLOCK, dtype=jnp.int32) * Q_BLOCK
    o = lax.map(block, starts)
    return jnp.transpose(o, (1, 0, 3, 2, 4)).reshape(B, S, ATTN_HEADS, ATTN_V_DIM)


def causal_depthwise_conv(x, w, b):
    C = x.shape[-1]
    y = lax.conv_general_dilated(x, w[:, None, :], window_strides=(1,),
                                 padding=[(CONV_WIDTH - 1, 0)],
                                 dimension_numbers=('NWC', 'WIO', 'NWC'),
                                 feature_group_count=C)
    return y + b


def rg_lru(x, w_a, b_a, w_i, b_i, lam_L):
    B, S, C = x.shape
    xb = x.reshape(B, S, RNN_BLOCKS, RNN_BLOCK_W)
    r = jax.nn.sigmoid(jnp.einsum('bsnc,ncd->bsnd', xb, w_a).reshape(B, S, C) + b_a).astype(jnp.float32)
    i = jax.nn.sigmoid(jnp.einsum('bsnc,ncd->bsnd', xb, w_i).reshape(B, S, C) + b_i).astype(jnp.float32)
    log_a = RG_LRU_C * r * jax.nn.log_sigmoid(lam_L.astype(jnp.float32))
    a = jnp.exp(log_a)
    u = jnp.sqrt(-jnp.expm1(2.0 * log_a)) * (i * x.astype(jnp.float32))

    def combine(left, right):
        a1, b1 = left
        a2, b2 = right
        return a1 * a2, a2 * b1 + b2

    _, h = lax.associative_scan(combine, (a, u), axis=1)
    return h.astype(x.dtype)


def setup_inputs(seed: int = 0) -> dict:
    key = jax.random.key(seed)
    ks = jax.random.split(key, 32)
    f32 = jnp.float32
    nrm = lambda k, shape, s: jax.random.normal(k, shape, f32) * s
    u = jax.random.uniform(ks[21], (DEPTH, RNN_WIDTH), f32, 0.9, 0.999)
    s_a = u ** (1.0 / RG_LRU_C)
    lru_L = jnp.log(s_a) - jnp.log1p(-s_a)
    return {
        "x": nrm(ks[0], (BATCH, SEQ, D_MODEL), 1.0),
        "c": nrm(ks[1], (BATCH, D_MODEL), 1.0),
        "rel_bias": nrm(ks[2], (N_BUCKETS, 2 * ATTN_HEADS), 0.5),
        "ada_w": nrm(ks[3], (DEPTH, D_MODEL, N_MOD * D_MODEL), 0.5 * D_MODEL ** -0.5),
        "ada_b": nrm(ks[4], (DEPTH, N_MOD * D_MODEL), 0.02),
        "norm_g": 1.0 + nrm(ks[5], (DEPTH, 3, D_MODEL), 0.02),
        "ffn1_w1": nrm(ks[6], (DEPTH, D_MODEL, D_FF), D_MODEL ** -0.5),
        "ffn1_w3": nrm(ks[7], (DEPTH, D_MODEL, D_FF), D_MODEL ** -0.5),
        "ffn1_w2": nrm(ks[8], (DEPTH, D_FF, D_MODEL), D_FF ** -0.5),
        "w_in": nrm(ks[9], (DEPTH, D_MODEL, D_IN), D_MODEL ** -0.5),
        "lam_q1": nrm(ks[10], (DEPTH, ATTN_QK_DIM), 0.1),
        "lam_k1": nrm(ks[11], (DEPTH, ATTN_QK_DIM), 0.1),
        "lam_q2": nrm(ks[12], (DEPTH, ATTN_QK_DIM), 0.1),
        "lam_k2": nrm(ks[13], (DEPTH, ATTN_QK_DIM), 0.1),
        "subln_g": 1.0 + nrm(ks[14], (DEPTH, ATTN_V_DIM), 0.02),
        "conv_w": nrm(ks[15], (DEPTH, CONV_WIDTH, RNN_WIDTH), CONV_WIDTH ** -0.5),
        "conv_b": nrm(ks[16], (DEPTH, RNN_WIDTH), 0.01),
        "gate_a_w": nrm(ks[17], (DEPTH, RNN_BLOCKS, RNN_BLOCK_W, RNN_BLOCK_W), RNN_BLOCK_W ** -0.5),
        "gate_a_b": nrm(ks[18], (DEPTH, RNN_WIDTH), 0.01),
        "gate_i_w": nrm(ks[19], (DEPTH, RNN_BLOCKS, RNN_BLOCK_W, RNN_BLOCK_W), RNN_BLOCK_W ** -0.5),
        "gate_i_b": nrm(ks[20], (DEPTH, RNN_WIDTH), 0.01),
        "lru_L": lru_L,
        "w_out": nrm(ks[22], (DEPTH, D_MIX, D_MODEL), D_MIX ** -0.5),
        "ffn2_w1": nrm(ks[23], (DEPTH, D_MODEL, D_FF), D_MODEL ** -0.5),
        "ffn2_w3": nrm(ks[24], (DEPTH, D_MODEL, D_FF), D_MODEL ** -0.5),
        "ffn2_w2": nrm(ks[25], (DEPTH, D_FF, D_MODEL), D_FF ** -0.5),
        "final_g": 1.0 + nrm(ks[26], (D_MODEL,), 0.02),
    }


def reference(x, c, rel_bias, ada_w, ada_b, norm_g, ffn1_w1, ffn1_w3, ffn1_w2, w_in,
              lam_q1, lam_k1, lam_q2, lam_k2, subln_g, conv_w, conv_b,
              gate_a_w, gate_a_b, gate_i_w, gate_i_b, lru_L, w_out,
              ffn2_w1, ffn2_w3, ffn2_w2, final_g):
    B, S, _ = x.shape
    c_act = jax.nn.silu(c)
    for l in range(DEPTH):
        mod = jnp.einsum('bd,de->be', c_act, ada_w[l]) + ada_b[l]
        sh1, sc1, g1, sh2, sc2, g2, sh3, sc3, g3 = jnp.split(mod, N_MOD, axis=-1)

        h = modulate(rms_norm(x, norm_g[l, 0]), sh1, sc1)
        x = x + 0.5 * g1[:, None, :] * swiglu(h, ffn1_w1[l], ffn1_w3[l], ffn1_w2[l])

        h = modulate(rms_norm(x, norm_g[l, 1]), sh2, sc2)
        proj = h @ w_in[l]
        q, k, v, xr, gr = jnp.split(proj, IN_SPLITS, axis=-1)
        q = q.reshape(B, S, 2 * ATTN_HEADS, ATTN_QK_DIM).transpose(0, 2, 1, 3)
        k = k.reshape(B, S, 2 * ATTN_HEADS, ATTN_QK_DIM).transpose(0, 2, 1, 3)
        v = v.reshape(B, S, ATTN_HEADS, ATTN_V_DIM).transpose(0, 2, 1, 3)

        lambda_init = 0.8 - 0.6 * math.exp(-0.3 * l)
        lam = (jnp.exp(jnp.sum(lam_q1[l].astype(jnp.float32) * lam_k1[l].astype(jnp.float32)))
               - jnp.exp(jnp.sum(lam_q2[l].astype(jnp.float32) * lam_k2[l].astype(jnp.float32)))
               + lambda_init)
        o = diff_attention(q, k, v, rel_bias, lam)
        o = (rms_norm(o, subln_g[l]) * (1 - lambda_init)).reshape(B, S, ATTN_WIDTH)

        xr = causal_depthwise_conv(xr, conv_w[l], conv_b[l])
        hr = rg_lru(xr, gate_a_w[l], gate_a_b[l], gate_i_w[l], gate_i_b[l], lru_L[l])
        yr = hr * jax.nn.gelu(gr)

        mix = jnp.concatenate([o, yr], axis=-1) @ w_out[l]
        x = x + g2[:, None, :] * mix

        h = modulate(rms_norm(x, norm_g[l, 2]), sh3, sc3)
        x = x + 0.5 * g3[:, None, :] * swiglu(h, ffn2_w1[l], ffn2_w3[l], ffn2_w2[l])

    return rms_norm(x, final_g)
```

```cpp
#include <hip/hip_runtime.h>
#include <cstdint>
#include <cstdio>

namespace nv {
constexpr int Bn = 4, S = 8192, D = 1024, M = Bn * S, FF = 2816, DIN = 2560, NMOD = 9;
typedef unsigned short bf16_t;
__device__ __forceinline__ float bf2f(bf16_t v) { return __uint_as_float(((unsigned)v) << 16); }
__device__ __forceinline__ bf16_t f2bf(float f) { unsigned u = __float_as_uint(f); return (bf16_t)((u + 0x7fffu + ((u >> 16) & 1u)) >> 16); }
__device__ __forceinline__ float ldf(const float* p) { return *p; }
__device__ __forceinline__ float ldf(const bf16_t* p) { return bf2f(*p); }
__device__ __forceinline__ float siluf(float v) { return v / (1.f + expf(-v)); }
__device__ __forceinline__ float sigmoidf_(float v) { return 1.f / (1.f + expf(-v)); }
__device__ __forceinline__ float gelu_tanh(float v) { const float u = 0.7978845608028654f * (v + 0.044715f * v * v * v); return 0.5f * v * (1.f + tanhf(u)); }
__device__ __forceinline__ float wave_sum(float v) {
#pragma unroll
    for (int o = 1; o < 64; o <<= 1) v += __shfl_xor(v, o);
    return v;
}
__device__ __forceinline__ int t5_bucket(int n) {
    if (n < 16) return n;
    int l = 16 + (int)(logf((float)n / 16.f) / logf(8.f) * 16.f);
    return l < 31 ? l : 31;
}

__global__ void __launch_bounds__(256) k_mod(const float* c, const float* ada_w, const float* ada_b, float* mod,
                                             const float* lq1, const float* lk1, const float* lq2, const float* lk2, float* lam) {
    __shared__ float ca[Bn][D];
    for (int i = threadIdx.x; i < Bn * D; i += 256) ca[i / D][i % D] = siluf(c[i]);
    __syncthreads();
    const int e = blockIdx.x * 256 + threadIdx.x;
    float a0 = 0.f, a1 = 0.f, a2 = 0.f, a3 = 0.f;
    for (int d = 0; d < D; ++d) { const float w = ada_w[(size_t)d * (NMOD * D) + e]; a0 += ca[0][d] * w; a1 += ca[1][d] * w; a2 += ca[2][d] * w; a3 += ca[3][d] * w; }
    const float bb = ada_b[e];
    mod[0 * NMOD * D + e] = a0 + bb; mod[1 * NMOD * D + e] = a1 + bb; mod[2 * NMOD * D + e] = a2 + bb; mod[3 * NMOD * D + e] = a3 + bb;
    if (blockIdx.x == 0 && threadIdx.x < 64) {
        const float s1 = wave_sum(lq1[threadIdx.x] * lk1[threadIdx.x]), s2 = wave_sum(lq2[threadIdx.x] * lk2[threadIdx.x]);
        if (threadIdx.x == 0) lam[0] = expf(s1) - expf(s2) + 0.2f;
    }
}

__global__ void __launch_bounds__(256) k_norm_mod(const float* x, const float* g, const float* mod, bf16_t* h, int sh_idx, int pad_) {
    const int row = blockIdx.x * 4 + (threadIdx.x >> 6), lane = threadIdx.x & 63, b = row / S;
    const float* xr = x + (size_t)row * D; float v[16]; float ss = 0.f;
#pragma unroll
    for (int j = 0; j < 16; ++j) { v[j] = xr[lane + 64 * j]; ss += v[j] * v[j]; }
    const float rstd = rsqrtf(wave_sum(ss) * (1.f / D) + 1e-6f);
    const float* sh = mod + (size_t)b * NMOD * D + sh_idx * D; const float* sc = sh + D;
#pragma unroll
    for (int j = 0; j < 16; ++j) { const int cidx = lane + 64 * j; h[(size_t)row * D + cidx] = f2bf(v[j] * rstd * g[cidx] * (1.f + sc[cidx]) + sh[cidx]); }
}
__global__ void __launch_bounds__(256) k_final_norm(float* x, const float* g) {
    const int row = blockIdx.x * 4 + (threadIdx.x >> 6), lane = threadIdx.x & 63;
    float* xr = x + (size_t)row * D; float v[16]; float ss = 0.f;
#pragma unroll
    for (int j = 0; j < 16; ++j) { v[j] = xr[lane + 64 * j]; ss += v[j] * v[j]; }
    const float rstd = rsqrtf(wave_sum(ss) * (1.f / D) + 1e-6f);
#pragma unroll
    for (int j = 0; j < 16; ++j) xr[lane + 64 * j] = v[j] * rstd * g[lane + 64 * j];
}

template <int NB, class Epi, typename TA>
__global__ void __launch_bounds__(256) k_gemm(const TA* A, const float* B0, const float* B1, Epi epi, int lda, int ldb, int K, int pad_) {
    __shared__ float As[16][68]; __shared__ float Bs[NB][16][64];
    const int tid = threadIdx.x, tx = tid & 15, ty = tid >> 4, row0 = blockIdx.y * 64, col0 = blockIdx.x * 64;
    float acc[NB][4][4];
#pragma unroll
    for (int n = 0; n < NB; ++n)
#pragma unroll
        for (int i = 0; i < 4; ++i)
#pragma unroll
            for (int j = 0; j < 4; ++j) acc[n][i][j] = 0.f;
    for (int k0 = 0; k0 < K; k0 += 16) {
#pragma unroll
        for (int i = 0; i < 4; ++i) { const int idx = tid + 256 * i, r = idx >> 4, kk = idx & 15; As[kk][r] = ldf(A + (size_t)(row0 + r) * lda + k0 + kk); }
#pragma unroll
        for (int i = 0; i < 4; ++i) { const int idx = tid + 256 * i, kk = idx >> 6, n = idx & 63; Bs[0][kk][n] = B0[(size_t)(k0 + kk) * ldb + col0 + n]; if (NB == 2) Bs[NB - 1][kk][n] = B1[(size_t)(k0 + kk) * ldb + col0 + n]; }
        __syncthreads();
#pragma unroll
        for (int kk = 0; kk < 16; ++kk) {
            float a[4], b[NB][4];
#pragma unroll
            for (int i = 0; i < 4; ++i) a[i] = As[kk][ty * 4 + i];
#pragma unroll
            for (int n = 0; n < NB; ++n)
#pragma unroll
                for (int j = 0; j < 4; ++j) b[n][j] = Bs[n][kk][tx * 4 + j];
#pragma unroll
            for (int n = 0; n < NB; ++n)
#pragma unroll
                for (int i = 0; i < 4; ++i)
#pragma unroll
                    for (int j = 0; j < 4; ++j) acc[n][i][j] += a[i] * b[n][j];
        }
        __syncthreads();
    }
#pragma unroll
    for (int i = 0; i < 4; ++i)
#pragma unroll
        for (int j = 0; j < 4; ++j) {
            if constexpr (NB == 2) epi(row0 + ty * 4 + i, col0 + tx * 4 + j, acc[0][i][j], acc[1][i][j]);
            else epi(row0 + ty * 4 + i, col0 + tx * 4 + j, acc[0][i][j], 0.f);
        }
}
struct EpiSwiglu { bf16_t* U; __device__ void operator()(int r, int c, float g, float u) const { U[(size_t)r * FF + c] = f2bf(siluf(g) * u); } };
struct EpiResid { const float* xin; float* xout; const float* gate; float coef; float pad_;
    __device__ void operator()(int r, int c, float a, float) const { const int b = r / S; const size_t o = (size_t)r * D + c; xout[o] = xin[o] + coef * gate[(size_t)b * NMOD * D + c] * a; } };
struct EpiProj { bf16_t *q, *k, *v; float *xr, *gr;
    __device__ void operator()(int r, int c, float a, float) const {
        const size_t ro = (size_t)r * 512;
        if (c < 512) q[ro + c] = f2bf(a); else if (c < 1024) k[ro + c - 512] = f2bf(a); else if (c < 1536) v[ro + c - 1024] = f2bf(a);
        else if (c < 2048) xr[ro + c - 1536] = a; else gr[ro + c - 2048] = a; } };

__global__ void __launch_bounds__(256) k_attn(const bf16_t* q, const bf16_t* k, const bf16_t* v, const float* rel_bias, float* Opart) {
    const int b = blockIdx.z, m = blockIdx.y, h = m >> 1, i = blockIdx.x * 256 + threadIdx.x;
    __shared__ float tbl[128];
    if (threadIdx.x < 128) tbl[threadIdx.x] = rel_bias[t5_bucket(threadIdx.x) * 8 + m];
    __syncthreads();
    float qv[64];
    const bf16_t* qp = q + ((size_t)(b * S + i)) * 512 + m * 64;
#pragma unroll
    for (int d = 0; d < 64; ++d) qv[d] = bf2f(qp[d]) * 0.125f;
    float acc[128];
#pragma unroll
    for (int d = 0; d < 128; ++d) acc[d] = 0.f;
    float mx = -INFINITY, l = 0.f;
    const int jmax = i | 63;
    for (int j = 0; j <= jmax; ++j) {
        const bf16_t* kr = k + ((size_t)(b * S + j)) * 512 + m * 64;
        const bf16_t* vr = v + ((size_t)(b * S + j)) * 512 + h * 128;
        float s = 0.f;
#pragma unroll
        for (int d = 0; d < 64; ++d) s += qv[d] * bf2f(kr[d]);
        const int rel = i - j;
        s += tbl[rel >= 127 ? 127 : (rel < 0 ? 0 : rel)];
        if (j <= i) {
            if (s > mx) { const float corr = expf(mx - s); l *= corr;
#pragma unroll
                for (int d = 0; d < 128; ++d) acc[d] *= corr;
                mx = s; }
            const float p = expf(s - mx); l += p;
#pragma unroll
            for (int d = 0; d < 128; ++d) acc[d] += p * bf2f(vr[d]);
        }
    }
    const float rl = 1.f / l;
    float* op = Opart + ((size_t)(b * S + i) * 8 + m) * 128;
#pragma unroll
    for (int d = 0; d < 128; ++d) op[d] = acc[d] * rl;
}
__global__ void __launch_bounds__(256) k_attn_combine(const float* Opart, const float* lam, const float* subln_g, bf16_t* mix) {
    const int idx = blockIdx.x * 4 + (threadIdx.x >> 6), lane = threadIdx.x & 63, row = idx >> 2, h = idx & 3;
    const float lm = lam[0];
    const float* o1 = Opart + ((size_t)row * 8 + 2 * h) * 128; const float* o2 = o1 + 128;
    const float v0 = o1[lane] - lm * o2[lane], v1 = o1[lane + 64] - lm * o2[lane + 64];
    const float rstd = rsqrtf(wave_sum(v0 * v0 + v1 * v1) * (1.f / 128.f) + 1e-6f);
    mix[(size_t)row * D + h * 128 + lane] = f2bf(v0 * rstd * subln_g[lane] * 0.8f);
    mix[(size_t)row * D + h * 128 + lane + 64] = f2bf(v1 * rstd * subln_g[lane + 64] * 0.8f);
}

__global__ void __launch_bounds__(256) k_conv(const float* xr, const float* cw, const float* cb, float* xc) {
    const size_t idx = (size_t)blockIdx.x * 256 + threadIdx.x; const int c = idx & 511; const int row = (int)(idx >> 9), t = row % S;
    float a = cb[c];
#pragma unroll
    for (int j = 0; j < 4; ++j) { const int tt = t - 3 + j; if (tt >= 0) a += cw[j * 512 + c] * xr[(size_t)(row - 3 + j) * 512 + c]; }
    xc[idx] = a;
}
__global__ void __launch_bounds__(256) k_gates(const float* xc, const float* wa, const float* ba, const float* wi, const float* bi, const float* L, float* aout, float* uout) {
    const size_t idx = (size_t)blockIdx.x * 256 + threadIdx.x; const int c = idx & 511, n = c >> 6, d = c & 63; const size_t row = idx >> 9;
    const float* xb = xc + row * 512 + n * 64; float sa = ba[c], si = bi[c];
    for (int cc = 0; cc < 64; ++cc) { const float xv = xb[cc]; sa += xv * wa[(n * 64 + cc) * 64 + d]; si += xv * wi[(n * 64 + cc) * 64 + d]; }
    const float r = sigmoidf_(sa), ig = sigmoidf_(si);
    const float logsig = -log1pf(expf(-L[c]));
    const float log_a = 8.f * r * logsig;
    aout[idx] = expf(log_a);
    uout[idx] = sqrtf(-expm1f(2.f * log_a)) * (ig * xc[idx]);
}
__global__ void __launch_bounds__(64) k_scan(const float* a, const float* u, const float* gr, bf16_t* mix) {
    const int gc = blockIdx.x * 64 + threadIdx.x, b = gc >> 9, c = gc & 511;
    float h = 0.f;
    for (int t = 0; t < S; ++t) { const size_t o = ((size_t)(b * S + t)) * 512 + c; h = a[o] * h + u[o]; mix[((size_t)(b * S + t)) * D + 512 + c] = f2bf(h * gelu_tanh(gr[o])); }
}
}

extern "C" void kernel_launch(void* const* d_in, const int* in_sizes, int n_in, void* d_out, int out_size, void* d_ws, size_t ws_size, hipStream_t stream) {
    using namespace nv;
    const float* x = (const float*)d_in[0]; const float* c = (const float*)d_in[1]; const float* rel_bias = (const float*)d_in[2];
    const float* ada_w = (const float*)d_in[3]; const float* ada_b = (const float*)d_in[4]; const float* norm_g = (const float*)d_in[5];
    const float* f1w1 = (const float*)d_in[6]; const float* f1w3 = (const float*)d_in[7]; const float* f1w2 = (const float*)d_in[8];
    const float* w_in = (const float*)d_in[9];
    const float* lq1 = (const float*)d_in[10]; const float* lk1 = (const float*)d_in[11]; const float* lq2 = (const float*)d_in[12]; const float* lk2 = (const float*)d_in[13];
    const float* subln_g = (const float*)d_in[14]; const float* conv_w = (const float*)d_in[15]; const float* conv_b = (const float*)d_in[16];
    const float* gaw = (const float*)d_in[17]; const float* gab = (const float*)d_in[18]; const float* giw = (const float*)d_in[19]; const float* gib = (const float*)d_in[20];
    const float* lru_L = (const float*)d_in[21]; const float* w_out = (const float*)d_in[22];
    const float* f2w1 = (const float*)d_in[23]; const float* f2w3 = (const float*)d_in[24]; const float* f2w2 = (const float*)d_in[25]; const float* final_g = (const float*)d_in[26];
    float* out = (float*)d_out; unsigned char* ws = (unsigned char*)d_ws;
    constexpr size_t MiB = 1u << 20;
    float* mod = (float*)(ws + 1 * MiB); float* lam = (float*)(ws + 2 * MiB);
    bf16_t* H = (bf16_t*)(ws + 16 * MiB); bf16_t* U = (bf16_t*)(ws + 80 * MiB);
    bf16_t* qb = (bf16_t*)(ws + 80 * MiB); bf16_t* kb = (bf16_t*)(ws + 112 * MiB); bf16_t* vb = (bf16_t*)(ws + 144 * MiB); bf16_t* mix = (bf16_t*)(ws + 176 * MiB);
    float* xr = (float*)(ws + 256 * MiB); float* gr = (float*)(ws + 320 * MiB); float* xc = (float*)(ws + 384 * MiB); float* ub = (float*)(ws + 448 * MiB);
    float* Opart = (float*)(ws + 384 * MiB); float* ab = xr;
    if (ws_size < 512 * MiB) { fprintf(stderr, "ws too small: %zu\n", ws_size); return; }

    k_mod<<<NMOD * D / 256, 256, 0, stream>>>(c, ada_w, ada_b, mod, lq1, lk1, lq2, lk2, lam);
    k_norm_mod<<<M / 4, 256, 0, stream>>>(x, norm_g + 0 * D, mod, H, 0, 0);
    k_gemm<2, EpiSwiglu, bf16_t><<<dim3(FF / 64, M / 64), 256, 0, stream>>>(H, f1w1, f1w3, EpiSwiglu{U}, D, FF, D, 0);
    k_gemm<1, EpiResid, bf16_t><<<dim3(D / 64, M / 64), 256, 0, stream>>>(U, f1w2, nullptr, EpiResid{x, out, mod + 2 * D, 0.5f, 0.f}, FF, D, FF, 0);
    k_norm_mod<<<M / 4, 256, 0, stream>>>(out, norm_g + 1 * D, mod, H, 3, 0);
    k_gemm<1, EpiProj, bf16_t><<<dim3(DIN / 64, M / 64), 256, 0, stream>>>(H, w_in, nullptr, EpiProj{qb, kb, vb, xr, gr}, D, DIN, D, 0);
    k_attn<<<dim3(S / 256, 8, Bn), 256, 0, stream>>>(qb, kb, vb, rel_bias, Opart);
    k_attn_combine<<<M * 4 / 4, 256, 0, stream>>>(Opart, lam, subln_g, mix);
    k_conv<<<M * 512 / 256, 256, 0, stream>>>(xr, conv_w, conv_b, xc);
    k_gates<<<M * 512 / 256, 256, 0, stream>>>(xc, gaw, gab, giw, gib, lru_L, ab, ub);
    k_scan<<<Bn * 512 / 64, 64, 0, stream>>>(ab, ub, gr, mix);
    k_gemm<1, EpiResid, bf16_t><<<dim3(D / 64, M / 64), 256, 0, stream>>>(mix, w_out, nullptr, EpiResid{out, out, mod + 5 * D, 1.0f, 0.f}, D, D, D, 0);
    k_norm_mod<<<M / 4, 256, 0, stream>>>(out, norm_g + 2 * D, mod, H, 6, 0);
    k_gemm<2, EpiSwiglu, bf16_t><<<dim3(FF / 64, M / 64), 256, 0, stream>>>(H, f2w1, f2w3, EpiSwiglu{U}, D, FF, D, 0);
    k_gemm<1, EpiResid, bf16_t><<<dim3(D / 64, M / 64), 256, 0, stream>>>(U, f2w2, nullptr, EpiResid{out, out, mod + 8 * D, 0.5f, 0.f}, FF, D, FF, 0);
    k_final_norm<<<M / 4, 256, 0, stream>>>(out, final_g);
}
```

```cpp
#include <hip/hip_runtime.h>
#include <cstdint>
#include <cstdio>
#include <cmath>

#ifndef MK_STAGE
#define MK_STAGE 4
#endif

constexpr int BATCH = 4, SEQ = 8192, DM = 1024, MTOK = BATCH * SEQ, DFF = 2816, DIN = 2560, NMOD = 9;
constexpr int PQ = 0, PK = 512, PV = 1024, PXR = 1536, PGR = 2048;
constexpr float LOG2E = 1.4426950408889634f;
constexpr float QSCALE = 0.125f * LOG2E;

#if MK_STAGE < 3
namespace nv {
constexpr int S = SEQ, D = DM;
typedef unsigned short bf16_t;
__device__ __forceinline__ float bf2f(bf16_t v) { return __uint_as_float(((unsigned)v) << 16); }
__device__ __forceinline__ bf16_t f2bf(float f) { unsigned u = __float_as_uint(f); return (bf16_t)((u + 0x7fffu + ((u >> 16) & 1u)) >> 16); }
__device__ __forceinline__ float sigmoidf_(float v) { return 1.f / (1.f + expf(-v)); }
__device__ __forceinline__ float gelu_tanh(float v) { const float u = 0.7978845608028654f * (v + 0.044715f * v * v * v); return 0.5f * v * (1.f + tanhf(u)); }
__device__ __forceinline__ float wave_sum(float v) {
#pragma unroll
    for (int o = 1; o < 64; o <<= 1) v += __shfl_xor(v, o);
    return v;
}
__device__ __forceinline__ int t5_bucket(int n) { if (n < 16) return n; int l = 16 + (int)(logf((float)n / 16.f) / logf(8.f) * 16.f); return l < 31 ? l : 31; }
__global__ void __launch_bounds__(256) k_attn(const bf16_t* P, const float* rel_bias, float* Opart) {
    const int b = blockIdx.z, m = blockIdx.y, h = m >> 1, i = blockIdx.x * 256 + threadIdx.x;
    __shared__ float tbl[128];
    if (threadIdx.x < 128) tbl[threadIdx.x] = rel_bias[t5_bucket(threadIdx.x) * 8 + m];
    __syncthreads();
    float qv[64];
    const bf16_t* qp = P + ((size_t)(b * S + i)) * DIN + PQ + m * 64;
#pragma unroll
    for (int d = 0; d < 64; ++d) qv[d] = bf2f(qp[d]) * 0.6931471805599453f;
    float acc[128];
#pragma unroll
    for (int d = 0; d < 128; ++d) acc[d] = 0.f;
    float mx = -INFINITY, l = 0.f;
    const int jmax = i | 63;
    for (int j = 0; j <= jmax; ++j) {
        const bf16_t* kr = P + ((size_t)(b * S + j)) * DIN + PK + m * 64;
        const bf16_t* vr = P + ((size_t)(b * S + j)) * DIN + PV + h * 128;
        float s = 0.f;
#pragma unroll
        for (int d = 0; d < 64; ++d) s += qv[d] * bf2f(kr[d]);
        const int rel = i - j;
        s += tbl[rel >= 127 ? 127 : (rel < 0 ? 0 : rel)];
        if (j <= i) {
            if (s > mx) { const float corr = expf(mx - s); l *= corr;
#pragma unroll
                for (int d = 0; d < 128; ++d) acc[d] *= corr;
                mx = s; }
            const float p = expf(s - mx); l += p;
#pragma unroll
            for (int d = 0; d < 128; ++d) acc[d] += p * bf2f(vr[d]);
        }
    }
    const float rl = 1.f / l;
    float* op = Opart + ((size_t)(b * S + i) * 8 + m) * 128;
#pragma unroll
    for (int d = 0; d < 128; ++d) op[d] = acc[d] * rl;
}
__global__ void __launch_bounds__(256) k_attn_combine(const float* Opart, const float* lam, const float* subln_g, bf16_t* mix) {
    const int idx = blockIdx.x * 4 + (threadIdx.x >> 6), lane = threadIdx.x & 63, row = idx >> 2, h = idx & 3;
    const float lm = lam[0];
    const float* o1 = Opart + ((size_t)row * 8 + 2 * h) * 128; const float* o2 = o1 + 128;
    const float v0 = o1[lane] - lm * o2[lane], v1 = o1[lane + 64] - lm * o2[lane + 64];
    const float rstd = rsqrtf(wave_sum(v0 * v0 + v1 * v1) * (1.f / 128.f) + 1e-6f);
    mix[(size_t)row * D + h * 128 + lane] = f2bf(v0 * rstd * subln_g[lane] * 0.8f);
    mix[(size_t)row * D + h * 128 + lane + 64] = f2bf(v1 * rstd * subln_g[lane + 64] * 0.8f);
}
__global__ void __launch_bounds__(256) k_conv(const bf16_t* P, const float* cw, const float* cb, float* xc) {
    const size_t idx = (size_t)blockIdx.x * 256 + threadIdx.x; const int c = idx & 511; const int row = (int)(idx >> 9), t = row % S;
    float a = cb[c];
#pragma unroll
    for (int j = 0; j < 4; ++j) { const int tt = t - 3 + j; if (tt >= 0) a += cw[j * 512 + c] * bf2f(P[(size_t)(row - 3 + j) * DIN + PXR + c]); }
    xc[idx] = a;
}
__global__ void __launch_bounds__(256) k_gates(const float* xc, const float* wa, const float* ba, const float* wi, const float* bi, const float* L, float* aout, float* uout) {
    const size_t idx = (size_t)blockIdx.x * 256 + threadIdx.x; const int c = idx & 511, n = c >> 6, d = c & 63; const size_t row = idx >> 9;
    const float* xb = xc + row * 512 + n * 64; float sa = ba[c], si = bi[c];
    for (int cc = 0; cc < 64; ++cc) { const float xv = xb[cc]; sa += xv * wa[(n * 64 + cc) * 64 + d]; si += xv * wi[(n * 64 + cc) * 64 + d]; }
    const float r = sigmoidf_(sa), ig = sigmoidf_(si);
    const float logsig = -log1pf(expf(-L[c]));
    const float log_a = 8.f * r * logsig;
    aout[idx] = expf(log_a);
    uout[idx] = sqrtf(-expm1f(2.f * log_a)) * (ig * xc[idx]);
}
__global__ void __launch_bounds__(64) k_scan(const float* a, const float* u, const bf16_t* P, bf16_t* mix) {
    const int gc = blockIdx.x * 64 + threadIdx.x, b = gc >> 9, c = gc & 511;
    float h = 0.f;
    for (int t = 0; t < S; ++t) { const size_t o = ((size_t)(b * S + t)) * 512 + c; h = a[o] * h + u[o];
        mix[((size_t)(b * S + t)) * D + 512 + c] = f2bf(h * gelu_tanh(bf2f(P[((size_t)(b * S + t)) * DIN + PGR + c]))); }
}
}
#endif

namespace pg8 {
#define PG8_LAS __attribute__((address_space(3)))
typedef unsigned short bf16_t;
typedef short bf16x8 __attribute__((ext_vector_type(8)));
typedef float f32x4 __attribute__((ext_vector_type(4)));
typedef unsigned u32x4 __attribute__((ext_vector_type(4)));
constexpr int BM = 256, BK = 64, HALF = 128, HTB = HALF * BK * 2  , STAGE_BYTES = 8 * HTB, NXCD = 8, WGM = 8;

__host__ __device__ __forceinline__ int lds_byte(int r, int c) { const int st = (r >> 4) * 2 + (c >> 5), rr = r & 15, cc = c & 31, ob = rr * 64 + cc * 2; return st * 1024 + (ob ^ (((ob >> 9) & 1) << 5)); }
__host__ __device__ __forceinline__ void stage_rc(int b, int& R, int& C) { const int st = b / 1024, sb = b % 1024, swz = sb ^ (((sb >> 9) & 1) << 5); R = (st >> 1) * 16 + swz / 64; C = (st & 1) * 32 + (swz % 64) / 2; }
__host__ __device__ __forceinline__ int perm32(int rho) { const int n = rho >> 4, i = rho & 15; return 8 * (i >> 2) + 4 * n + (i & 3); }

struct Unit { int pm, pn; };
struct Gemm { const bf16_t* A; const bf16_t* Bt; int M, N, K; };

struct StaticOrder {
    int nM, nN, nwg, G, c;
    __host__ __device__ void init(int M, int N, int G_, int c_) { nM = M / BM; nN = N / BM; nwg = nM * nN; G = G_; c = c_; }
    __host__ __device__ bool next(int i, Unit& u) const {
        const long L = (long)i * G + c; if (L >= nwg) return false;
        int wgid = (int)L; { const int q = nwg / NXCD, r = nwg % NXCD, xcd = wgid % NXCD, off = wgid / NXCD; wgid = (xcd < r ? xcd * (q + 1) : r * (q + 1) + (xcd - r) * q) + off; }
        const int nig = WGM * nN, gid = wgid / nig, fm = gid * WGM, gsz = (nM - fm) < WGM ? (nM - fm) : WGM;
        u.pm = fm + ((wgid % nig) % gsz); u.pn = (wgid % nig) / gsz; return true;
    }
    __device__ __forceinline__ void a_ready(const Unit&) const {}
    __device__ __forceinline__ void done(const Unit&) const {}
};

__device__ __forceinline__ unsigned cvt_pk_bf16(float lo, float hi) { unsigned r; asm volatile("v_cvt_pk_bf16_f32 %0, %1, %2" : "=v"(r) : "v"(lo), "v"(hi)); return r; }
__device__ __forceinline__ float fast_silu(float g) { return g * __builtin_amdgcn_rcpf(1.f + __builtin_amdgcn_exp2f(-1.4426950408889634f * g)); }

struct EpiSwiglu {
    static constexpr bool PERM = true, AFTER_DRAIN = false;
    bf16_t* U;
    __device__ __forceinline__ void operator()(const f32x4 (&acc)[2][2][4][2], const Unit& u, int wr, int wc, int fr, int fq) const {
        const int row0 = u.pm * BM + wr * 64 + fr, col0 = u.pn * 128 + wc * 32 + 8 * fq;
#pragma unroll
        for (int ai = 0; ai < 2; ++ai)
#pragma unroll
            for (int m = 0; m < 4; ++m) {
                bf16_t* rowp = U + (size_t)(row0 + ai * HALF + m * 16) * DFF + col0;
                const f32x4 g0 = acc[ai][0][m][0], g1 = acc[ai][0][m][1], u0 = acc[ai][1][m][0], u1 = acc[ai][1][m][1];
                u32x4 w;
                w.x = cvt_pk_bf16(fast_silu(g0[0]) * u0[0], fast_silu(g0[1]) * u0[1]); w.y = cvt_pk_bf16(fast_silu(g0[2]) * u0[2], fast_silu(g0[3]) * u0[3]);
                w.z = cvt_pk_bf16(fast_silu(g1[0]) * u1[0], fast_silu(g1[1]) * u1[1]); w.w = cvt_pk_bf16(fast_silu(g1[2]) * u1[2], fast_silu(g1[3]) * u1[3]);
                *(u32x4*)rowp = w;
            }
    }
};
struct EpiResid {
    static constexpr bool PERM = false, AFTER_DRAIN = false;
    const float* xin; float* xout; const float* gate; float coef;
    __device__ __forceinline__ void operator()(const f32x4 (&acc)[2][2][4][2], const Unit& u, int wr, int wc, int fr, int fq) const {
        const int row0 = u.pm * BM + wr * 64 + fr, col0 = u.pn * BM + wc * 32 + 4 * fq, b = (u.pm * BM) / SEQ;
        f32x4 gv[2][2];
#pragma unroll
        for (int bj = 0; bj < 2; ++bj)
#pragma unroll
            for (int n = 0; n < 2; ++n) gv[bj][n] = *(const f32x4*)(gate + (size_t)b * NMOD * DM + col0 + bj * HALF + n * 16) * coef;
#pragma unroll
        for (int ai = 0; ai < 2; ++ai)
#pragma unroll
            for (int m = 0; m < 4; ++m) { const size_t off = (size_t)(row0 + ai * HALF + m * 16) * DM + col0;
#pragma unroll
                for (int bj = 0; bj < 2; ++bj)
#pragma unroll
                    for (int n = 0; n < 2; ++n) { const f32x4 xi = *(const f32x4*)(xin + off + bj * HALF + n * 16); *(f32x4*)(xout + off + bj * HALF + n * 16) = xi + gv[bj][n] * acc[ai][bj][m][n]; } }
    }
};
struct EpiProj {
    static constexpr bool PERM = true, AFTER_DRAIN = false;
    bf16_t* P;
    __device__ __forceinline__ void operator()(const f32x4 (&acc)[2][2][4][2], const Unit& u, int wr, int wc, int fr, int fq) const {
        const int row0 = u.pm * BM + wr * 64 + fr, col0 = u.pn * BM + wc * 32 + 8 * fq; const float sc = (u.pn < 2) ? QSCALE : 1.f;
#pragma unroll
        for (int ai = 0; ai < 2; ++ai)
#pragma unroll
            for (int m = 0; m < 4; ++m) { bf16_t* rowp = P + (size_t)(row0 + ai * HALF + m * 16) * DIN + col0;
#pragma unroll
                for (int bj = 0; bj < 2; ++bj) { const f32x4 v0 = acc[ai][bj][m][0] * sc, v1 = acc[ai][bj][m][1] * sc; u32x4 w;
                    w.x = cvt_pk_bf16(v0[0], v0[1]); w.y = cvt_pk_bf16(v0[2], v0[3]); w.z = cvt_pk_bf16(v1[0], v1[1]); w.w = cvt_pk_bf16(v1[2], v1[3]);
                    *(u32x4*)(rowp + bj * HALF) = w; } }
    }
};

template <class Epi, class Sched, bool ALIGN_EPI = false, bool SP2 = false>
__device__ __forceinline__ void gemm_phase(PG8_LAS unsigned char* lds, const Gemm g, const Sched& S, const Epi& E) {
    int tid_ = threadIdx.x; asm volatile("" : "+v"(tid_));
    const int tid = tid_, wid = __builtin_amdgcn_readfirstlane(tid >> 6), lane = tid & 63, wr = wid >> 2, wc = wid & 3, fr = lane & 15, fq = lane >> 4;
    const int K = g.K, nt = K / BK;
    unsigned voffA[2], voffB[2];
#pragma unroll
    for (int i = 0; i < 2; ++i) { int R, C; stage_rc(tid * 16 + i * 8192, R, C); const int Rb = Epi::PERM ? ((R & ~31) + perm32(R & 31)) : R;
        voffA[i] = (unsigned)(R * K + C) * 2u; voffB[i] = (unsigned)(Rb * K + C) * 2u; }
    const size_t kstep = (size_t)(BK * 2);
    const size_t hstep = (size_t)HALF * K * 2;
    const size_t tstep = 2 * hstep;
    const unsigned ldsw = (unsigned)wid * 1024u;
    const int aoff = lds_byte(wr * 64 + fr, fq * 8), boff = lds_byte(wc * 32 + fr, fq * 8);
#define PG8_SA(b, h) (((b) * 2 + (h)) * HTB)
#define PG8_SB(b, h) ((4 + (b) * 2 + (h)) * HTB)
#define PG8_STAGE(bufoff, gbase, voff) do { _Pragma("unroll") for (int _i = 0; _i < 2; ++_i) \
        __builtin_amdgcn_global_load_lds((const unsigned*)((const char*)(gbase) + (voff)[_i]), (PG8_LAS unsigned*)(lds + (bufoff) + ldsw + _i * 8192), 16, 0, 0); } while (0)
#define PG8_LDA(dst, b, h) do { _Pragma("unroll") for (int m = 0; m < 4; ++m) _Pragma("unroll") for (int k = 0; k < 2; ++k) dst[m][k] = *(const PG8_LAS bf16x8*)(lds + PG8_SA(b, h) + aoff + m * 2048 + k * 1024); } while (0)
#define PG8_LDB(dst, b, h) do { _Pragma("unroll") for (int n = 0; n < 2; ++n) _Pragma("unroll") for (int k = 0; k < 2; ++k) dst[n][k] = *(const PG8_LAS bf16x8*)(lds + PG8_SB(b, h) + boff + n * 2048 + k * 1024); } while (0)
#define PG8_MMA(ai, bj, At, Bt) do { __builtin_amdgcn_s_setprio(1); _Pragma("unroll") for (int m = 0; m < 4; ++m) _Pragma("unroll") for (int n = 0; n < 2; ++n) _Pragma("unroll") for (int k = 0; k < 2; ++k) \
        acc[ai][bj][m][n] = __builtin_amdgcn_mfma_f32_16x16x32_bf16(Bt[n][k], At[m][k], acc[ai][bj][m][n], 0, 0, 0); __builtin_amdgcn_s_setprio(0); } while (0)
#define PG8_WAIT_V(n) asm volatile("s_waitcnt vmcnt(" #n ")" ::: "memory")
#define PG8_WAIT_L(n) asm volatile("s_waitcnt lgkmcnt(" #n ")" ::: "memory")
#define PG8_BAR __builtin_amdgcn_s_barrier()
#define PG8_SCHED __builtin_amdgcn_sched_barrier(0)
    Unit cur, nxt; int ui = 0;
    if (!S.next(0, cur)) return;
    f32x4 acc[2][2][4][2];
#pragma unroll
    for (int a = 0; a < 2; ++a)
#pragma unroll
        for (int b = 0; b < 2; ++b)
#pragma unroll
            for (int m = 0; m < 4; ++m)
#pragma unroll
                for (int n = 0; n < 2; ++n) acc[a][b][m][n] = (f32x4){0.f, 0.f, 0.f, 0.f};
    bf16x8 At[4][2], B0[2][2], B1[2][2];
    const char* cA = (const char*)g.A + (size_t)cur.pm * tstep; const char* cB = (const char*)g.Bt + (size_t)cur.pn * tstep;
    S.a_ready(cur);
    if constexpr (SP2) {
        PG8_STAGE(PG8_SB(0, 0), cB, voffB); PG8_STAGE(PG8_SB(0, 1), cB + hstep, voffB); PG8_STAGE(PG8_SA(0, 0), cA, voffA); PG8_STAGE(PG8_SA(0, 1), cA + hstep, voffA);
        if (wr == 1) PG8_BAR;
        PG8_WAIT_V(2); PG8_BAR;
        PG8_STAGE(PG8_SB(1, 0), cB + kstep, voffB); PG8_STAGE(PG8_SA(1, 0), cA + kstep, voffA); PG8_STAGE(PG8_SB(1, 1), cB + hstep + kstep, voffB);
        PG8_WAIT_V(6); PG8_BAR;
    } else {
        PG8_STAGE(PG8_SB(0, 0), cB, voffB); PG8_STAGE(PG8_SA(0, 0), cA, voffA); PG8_STAGE(PG8_SB(0, 1), cB + hstep, voffB); PG8_STAGE(PG8_SA(0, 1), cA + hstep, voffA);
        if (wr == 1) PG8_BAR;
        PG8_WAIT_V(4); PG8_BAR;
        PG8_STAGE(PG8_SB(1, 0), cB + kstep, voffB); PG8_STAGE(PG8_SA(1, 0), cA + kstep, voffA); PG8_STAGE(PG8_SB(1, 1), cB + hstep + kstep, voffB);
        PG8_WAIT_V(6); PG8_BAR;
    }
    for (;;) {
        const bool has_next = S.next(ui + 1, nxt);
        const char* nA = has_next ? (const char*)g.A + (size_t)nxt.pm * tstep : cA; const char* nB = has_next ? (const char*)g.Bt + (size_t)nxt.pn * tstep : cB;
        for (int t = 0; t < nt; t += 2) {
            const bool last = (t == nt - 2);
            const char* a1 = cA + (size_t)(t + 1) * kstep;
            const char* a2 = last ? nA : cA + (size_t)(t + 2) * kstep; const char* b2 = last ? nB : cB + (size_t)(t + 2) * kstep;
            const char* a3 = a2 + kstep; const char* b3 = b2 + kstep;
            if (last && has_next) S.a_ready(nxt);
            if constexpr (SP2) {
            PG8_LDB(B0, 0, 0); PG8_LDB(B1, 0, 1); PG8_SCHED; PG8_LDA(At, 0, 0); PG8_STAGE(PG8_SA(1, 1), a1 + hstep, voffA);
            PG8_WAIT_V(8); PG8_WAIT_L(0); PG8_BAR; PG8_MMA(0, 0, At, B0); PG8_MMA(0, 1, At, B1); PG8_BAR; PG8_SCHED;
            PG8_LDA(At, 0, 1); PG8_STAGE(PG8_SB(0, 0), b2, voffB); PG8_STAGE(PG8_SB(0, 1), b2 + hstep, voffB); PG8_STAGE(PG8_SA(0, 0), a2, voffA);
            PG8_WAIT_V(8); PG8_WAIT_L(0); PG8_BAR; PG8_MMA(1, 0, At, B0); PG8_MMA(1, 1, At, B1); PG8_BAR; PG8_SCHED;
            PG8_LDB(B0, 1, 0); PG8_LDB(B1, 1, 1); PG8_SCHED; PG8_LDA(At, 1, 0); PG8_STAGE(PG8_SA(0, 1), a2 + hstep, voffA);
            PG8_WAIT_V(8); PG8_WAIT_L(0); PG8_BAR; PG8_MMA(0, 0, At, B0); PG8_MMA(0, 1, At, B1); PG8_BAR; PG8_SCHED;
            PG8_LDA(At, 1, 1); PG8_STAGE(PG8_SB(1, 0), b3, voffB); PG8_STAGE(PG8_SB(1, 1), b3 + hstep, voffB); PG8_STAGE(PG8_SA(1, 0), a3, voffA);
            PG8_WAIT_V(8); PG8_WAIT_L(0); PG8_BAR; PG8_MMA(1, 0, At, B0); PG8_MMA(1, 1, At, B1); PG8_BAR; PG8_SCHED;
            } else {
            PG8_LDB(B0, 0, 0); PG8_SCHED; PG8_LDA(At, 0, 0); PG8_STAGE(PG8_SA(1, 1), a1 + hstep, voffA);
            PG8_WAIT_L(8); PG8_BAR; PG8_WAIT_L(0); PG8_MMA(0, 0, At, B0); PG8_BAR; PG8_SCHED;
            PG8_LDB(B1, 0, 1); PG8_STAGE(PG8_SB(0, 0), b2, voffB);
            PG8_BAR; PG8_WAIT_L(0); PG8_MMA(0, 1, At, B1); PG8_BAR;
            PG8_LDA(At, 0, 1); PG8_STAGE(PG8_SA(0, 0), a2, voffA);
            PG8_BAR; PG8_WAIT_L(0); PG8_MMA(1, 0, At, B0); PG8_BAR; PG8_SCHED;
            PG8_STAGE(PG8_SB(0, 1), b2 + hstep, voffB);
            PG8_WAIT_V(6); PG8_BAR; PG8_MMA(1, 1, At, B1); PG8_BAR;
            PG8_LDB(B0, 1, 0); PG8_SCHED; PG8_LDA(At, 1, 0); PG8_STAGE(PG8_SA(0, 1), a2 + hstep, voffA);
            PG8_WAIT_L(8); PG8_BAR; PG8_WAIT_L(0); PG8_MMA(0, 0, At, B0); PG8_BAR; PG8_SCHED;
            PG8_LDB(B1, 1, 1); PG8_STAGE(PG8_SB(1, 0), b3, voffB);
            PG8_BAR; PG8_WAIT_L(0); PG8_MMA(0, 1, At, B1); PG8_BAR;
            PG8_LDA(At, 1, 1); PG8_STAGE(PG8_SA(1, 0), a3, voffA);
            PG8_BAR; PG8_WAIT_L(0); PG8_MMA(1, 0, At, B0); PG8_BAR; PG8_SCHED;
            PG8_STAGE(PG8_SB(1, 1), b3 + hstep, voffB);
            PG8_WAIT_V(6); PG8_BAR; PG8_MMA(1, 1, At, B1); PG8_BAR;
            }
        }
        if constexpr (ALIGN_EPI) { if (wr == 0) PG8_BAR; }
        if constexpr (!Epi::AFTER_DRAIN) { E(acc, cur, wr, wc, fr, fq); S.done(cur); }
        if (!has_next) break;
#pragma unroll
        for (int a = 0; a < 2; ++a)
#pragma unroll
            for (int b = 0; b < 2; ++b)
#pragma unroll
                for (int m = 0; m < 4; ++m)
#pragma unroll
                    for (int n = 0; n < 2; ++n) acc[a][b][m][n] = (f32x4){0.f, 0.f, 0.f, 0.f};
        cur = nxt; cA = nA; cB = nB; ++ui;
        if constexpr (ALIGN_EPI) { if (wr == 1) PG8_BAR; }
    }
    PG8_WAIT_V(0);
    if constexpr (!ALIGN_EPI) { if (wr == 0) PG8_BAR; }
    PG8_BAR;
    if constexpr (Epi::AFTER_DRAIN) { E.fused(acc, cur, wr, wc, fr, fq, lds, wid, lane); S.done(cur); }
#undef PG8_SA
#undef PG8_SB
#undef PG8_STAGE
#undef PG8_LDA
#undef PG8_LDB
#undef PG8_MMA
#undef PG8_WAIT_V
#undef PG8_WAIT_L
#undef PG8_BAR
#undef PG8_SCHED
}
}

namespace att {
typedef unsigned short bf16_t;
using bf16x8 = __attribute__((ext_vector_type(8))) short;
using s16x4 = __attribute__((ext_vector_type(4))) short;
using f32x16 = __attribute__((ext_vector_type(16))) float;
using u32x4 = __attribute__((ext_vector_type(4))) unsigned;
using f32x4v = __attribute__((ext_vector_type(4))) float;
#define ALAS __attribute__((address_space(3)))
typedef ALAS const char* lds_cptr;
typedef ALAS char* lds_ptr;
typedef short v4i16_t __attribute__((ext_vector_type(4)));
constexpr int QB = 128, KVBLK = 64, NQB = SEQ / QB;
constexpr int KSLOT = 16384, NSLOT = 3, TBLN = 384;
constexpr int L_K = 0, L_V = NSLOT * KSLOT, L_TBL = 2 * NSLOT * KSLOT, L_WSF = L_TBL + 2 * TBLN * 4, L_Q = L_WSF + 8 * 64 * 4, L_END = L_Q + 8 * 4096;
constexpr float THR = 8.f;
#define AMFMA(a, b, c) __builtin_amdgcn_mfma_f32_32x32x16_bf16(a, b, c, 0, 0, 0)
#define AWAIT_BAR(N) asm volatile("s_waitcnt vmcnt(" #N ") lgkmcnt(0)\n\ts_barrier" ::: "memory")
__device__ __forceinline__ int crow(int r, int hi) { return (r & 3) + 8 * (r >> 2) + 4 * hi; }
__device__ __forceinline__ void glds16(const void* gsrc, unsigned lds_dst) { unsigned keep;
    asm volatile("s_mov_b32 %0, m0\n\ts_mov_b32 m0, %2\n\ts_nop 0\n\tglobal_load_lds_dwordx4 %1, off\n\ts_mov_b32 m0, %0" : "=&s"(keep) : "v"(gsrc), "s"(lds_dst) : "memory"); }
__device__ __forceinline__ s16x4 vtr(lds_cptr p) { return __builtin_bit_cast(s16x4, __builtin_amdgcn_ds_read_tr16_b64_v4i16((ALAS v4i16_t*)p)); }
__device__ __forceinline__ unsigned cvtpk(float lo, float hi) { typedef float f2 __attribute__((ext_vector_type(2))); typedef __bf16 b2 __attribute__((ext_vector_type(2))); f2 v = {lo, hi}; b2 b = __builtin_convertvector(v, b2); return __builtin_bit_cast(unsigned, b); }
__device__ __forceinline__ bf16_t f2bf(float f) { unsigned u = __float_as_uint(f); return (bf16_t)((u + 0x7fffu + ((u >> 16) & 1u)) >> 16); }
__device__ __forceinline__ int t5_bucket(int n) { if (n < 16) return n; int l = 16 + (int)(logf((float)n / 16.f) / logf(8.f) * 16.f); return l < 31 ? l : 31; }
#define MX3(a, b, c) __builtin_fmaxf(__builtin_fmaxf((a), (b)), (c))
__device__ __forceinline__ float rowmax(const f32x16& p0, const f32x16& p1) {
    float a = MX3(p0[0], p0[1], p1[0]), b = MX3(p0[2], p0[3], p1[1]); a = MX3(a, p1[2], p1[3]);
#pragma unroll
    for (int r = 4; r < 16; r += 4) { a = MX3(a, p0[r], p0[r + 1]); b = MX3(b, p0[r + 2], p0[r + 3]); a = MX3(a, p1[r], p1[r + 1]); b = MX3(b, p1[r + 2], p1[r + 3]); }
    float m = __builtin_fmaxf(a, b); auto rr = __builtin_amdgcn_permlane32_swap(__float_as_uint(m), __float_as_uint(m), false, false);
    return __builtin_fmaxf(__uint_as_float(rr[0]), __uint_as_float(rr[1])); }

template <bool BAND>
__device__ __forceinline__ void tile(f32x16 (&o)[4], float& mhat, float& lreg, f32x16& negm, lds_cptr qp, lds_cptr kp, lds_cptr vp, const ALAS float* tb, ALAS float* wsf, bool first, float bfar, int r32, int hi) {
    bf16x8 kf[8], qr[4];
#pragma unroll
    for (int d0 = 0; d0 < 4; ++d0) qr[d0] = *(const ALAS bf16x8*)(qp + d0 * 1024);
#pragma unroll
    for (int d0 = 0; d0 < 4; ++d0) { kf[2 * d0] = *(const ALAS bf16x8*)(kp + d0 * 2048); kf[2 * d0 + 1] = *(const ALAS bf16x8*)(kp + d0 * 2048 + 512); }
    f32x16 C0 = AMFMA(kf[0], qr[0], negm), C1 = AMFMA(kf[1], qr[0], negm);
#pragma unroll
    for (int d0 = 1; d0 < 4; ++d0) { C0 = AMFMA(kf[2 * d0], qr[d0], C0); C1 = AMFMA(kf[2 * d0 + 1], qr[d0], C1); }
    if (BAND) {
#pragma unroll
        for (int r = 0; r < 16; ++r) { const int c = (r & 3) + 8 * (r >> 2); C0[r] += tb[-c]; C1[r] += tb[-c - 32]; }
    }
    const float rm = rowmax(C0, C1);
    if (first) {
        mhat = rm;
#pragma unroll
        for (int r = 0; r < 16; ++r) { C0[r] -= rm; C1[r] -= rm; negm[r] = bfar - mhat; }
    } else if (__any(rm > THR)) {
        const float dl = __builtin_fmaxf(rm, 0.f); mhat += dl;
#pragma unroll
        for (int r = 0; r < 16; ++r) { C0[r] -= dl; C1[r] -= dl; negm[r] = bfar - mhat; }
        const float f = __builtin_amdgcn_exp2f(-dl); lreg *= f;
        if (hi == 0) wsf[r32] = f;
#pragma unroll
        for (int r = 0; r < 16; ++r) { const float fr = wsf[crow(r, hi)];
#pragma unroll
            for (int d0 = 0; d0 < 4; ++d0) o[d0][r] *= fr; }
    }
    float sacc = 0.f;
#pragma unroll
    for (int r = 0; r < 16; ++r) { C0[r] = __builtin_amdgcn_exp2f(C0[r]); C1[r] = __builtin_amdgcn_exp2f(C1[r]); sacc += C0[r] + C1[r]; }
    lreg += sacc;
    u32x4 pw[4];
    pw[0] = (u32x4){cvtpk(C0[0], C0[1]), cvtpk(C0[2], C0[3]), cvtpk(C0[4], C0[5]), cvtpk(C0[6], C0[7])};
    pw[1] = (u32x4){cvtpk(C0[8], C0[9]), cvtpk(C0[10], C0[11]), cvtpk(C0[12], C0[13]), cvtpk(C0[14], C0[15])};
    pw[2] = (u32x4){cvtpk(C1[0], C1[1]), cvtpk(C1[2], C1[3]), cvtpk(C1[4], C1[5]), cvtpk(C1[6], C1[7])};
    pw[3] = (u32x4){cvtpk(C1[8], C1[9]), cvtpk(C1[10], C1[11]), cvtpk(C1[12], C1[13]), cvtpk(C1[14], C1[15])};
#pragma unroll
    for (int d0 = 0; d0 < 4; ++d0)
#pragma unroll
        for (int s = 0; s < 4; ++s) {
            const s16x4 lo = vtr(vp + d0 * 4096 + s * 1024), hh = vtr(vp + d0 * 4096 + s * 1024 + 512);
            const bf16x8 vf = (bf16x8){lo[0], lo[1], lo[2], lo[3], hh[0], hh[1], hh[2], hh[3]};
            o[d0] = AMFMA(__builtin_bit_cast(bf16x8, pw[s]), vf, o[d0]);
            if (s == 3) __builtin_amdgcn_sched_barrier(0);
        }
}

__device__ __forceinline__ void unit(int b, int h, int qb, const bf16_t* __restrict__ P, bf16_t* mix, const float* relb, float lam, const float* subln, char* shm) {
    int tid_ = threadIdx.x; asm volatile("" : "+v"(tid_));
    const int tid = tid_, lane = tid & 63, r32 = lane & 31, hi = lane >> 5; const int wid = __builtin_amdgcn_readfirstlane(tid >> 6), mp = wid >> 2, wq = wid & 3;
    const long rowbase = (long)b * SEQ; const int q0 = qb * QB, NT = 2 * qb + 2;
    const unsigned lds0 = (unsigned)(uintptr_t)shm; const lds_ptr shm3 = (lds_ptr)shm;
    ALAS float* tbl = (ALAS float*)(shm3 + L_TBL); ALAS float* wsf = (ALAS float*)(shm3 + L_WSF) + wid * 64;
    for (int i = tid; i < 2 * TBLN; i += 512) { const int mm = i / TBLN, rel = (i - mm * TBLN) - 128; float v = -INFINITY;
        if (rel >= 0) v = (relb[t5_bucket(rel) * 8 + 2 * h + mm] - relb[31 * 8 + 2 * h + mm]) * LOG2E;
        tbl[i] = v; }
    const float bfar = relb[31 * 8 + 2 * h + mp] * LOG2E;
    const bf16_t* Pb = P + rowbase * DIN;
    const bf16_t* ksrc = Pb + (long)lane * DIN + PK + (2 * h) * 64 + wid * 8;
    const bf16_t* vsrc = Pb + (long)(16 * (wid & 3) + (lane >> 2)) * DIN + PV + h * 128 + (wid >> 2) * 32 + (lane & 3) * 8;
    const unsigned kdst = lds0 + L_K + wid * 1024, vdst = lds0 + L_V + wid * 1024;
#define ADMA(t, slot) do { const long go_ = (long)(t) * KVBLK * DIN; \
        glds16(ksrc + go_, (unsigned)__builtin_amdgcn_readfirstlane(kdst + (slot))); glds16(ksrc + go_ + 64, (unsigned)__builtin_amdgcn_readfirstlane(kdst + (slot) + 8192)); \
        glds16(vsrc + go_, (unsigned)__builtin_amdgcn_readfirstlane(vdst + (slot))); glds16(vsrc + go_ + 64, (unsigned)__builtin_amdgcn_readfirstlane(vdst + (slot) + 8192)); } while (0)
    const lds_cptr kp0 = (lds_cptr)shm3 + L_K + mp * 8192 + hi * 1024 + r32 * 16;
    const lds_cptr vp0 = (lds_cptr)shm3 + L_V + ((lane >> 4) & 1) * 32 + (lane & 3) * 8 + (4 * hi + ((lane & 15) >> 2)) * 64;
    const lds_ptr qp0 = shm3 + L_Q + wid * 4096 + lane * 16;
    { const bf16_t* Qw = Pb + (long)(q0 + 32 * wq + r32) * DIN + PQ + (2 * h + mp) * 64 + hi * 8;
#pragma unroll
      for (int d0 = 0; d0 < 4; ++d0) *(ALAS bf16x8*)(qp0 + d0 * 1024) = *reinterpret_cast<const bf16x8*>(Qw + d0 * 16); }
    ADMA(0, 0); ADMA(1, KSLOT);
    f32x16 o[4]; o[0] = f32x16{}; o[1] = f32x16{}; o[2] = f32x16{}; o[3] = f32x16{};
    float mhat = 0.f, lreg = 0.f; f32x16 negm;
#pragma unroll
    for (int r = 0; r < 16; ++r) negm[r] = bfar;
    const int qabs = q0 + 32 * wq + r32;
    const ALAS float* tbq = tbl + mp * TBLN + (qabs + 128 - 4 * hi);
    int sl = 0, sln = 2 * KSLOT;
    const int tband = NT > 4 ? NT - 4 : 0;
    int t = 0;
    for (; t < tband; ++t) {
        AWAIT_BAR(4);
        ADMA(t + 2, sln);
        tile<false>(o, mhat, lreg, negm, (lds_cptr)qp0, kp0 + sl, vp0 + sl, tbq, wsf, t == 0, bfar, r32, hi);
        sl = (sl == 2 * KSLOT) ? 0 : sl + KSLOT; sln = (sln == 2 * KSLOT) ? 0 : sln + KSLOT;
    }
    for (; t < NT; ++t) {
        if (t + 1 < NT) { AWAIT_BAR(4); } else { AWAIT_BAR(0); }
        if (t + 2 < NT) ADMA(t + 2, sln);
        tile<true>(o, mhat, lreg, negm, (lds_cptr)qp0, kp0 + sl, vp0 + sl, tbq - 64 * t, wsf, t == 0, bfar, r32, hi);
        sl = (sl == 2 * KSLOT) ? 0 : sl + KSLOT; sln = (sln == 2 * KSLOT) ? 0 : sln + KSLOT;
    }
#undef ADMA
    { auto rr = __builtin_amdgcn_permlane32_swap(__float_as_uint(lreg), __float_as_uint(lreg), false, false); lreg = __uint_as_float(rr[0]) + __uint_as_float(rr[1]); }
    if (hi == 0) wsf[32 + r32] = lreg;
#pragma unroll
    for (int r = 0; r < 16; ++r) { const float rl = __builtin_amdgcn_rcpf(wsf[32 + crow(r, hi)]);
#pragma unroll
        for (int d0 = 0; d0 < 4; ++d0) o[d0][r] *= rl; }
    AWAIT_BAR(0);
    ALAS float* ex = (ALAS float*)shm3 + wq * 4096;
    if (mp == 1) {
#pragma unroll
        for (int r = 0; r < 16; ++r)
#pragma unroll
            for (int d0 = 0; d0 < 4; ++d0) ex[crow(r, hi) * 128 + 32 * d0 + r32] = o[d0][r];
    }
    AWAIT_BAR(0);
    if (mp == 0) {
        float g[4];
#pragma unroll
        for (int d0 = 0; d0 < 4; ++d0) g[d0] = subln[32 * d0 + r32] * 0.8f;
#pragma unroll
        for (int r = 0; r < 16; ++r) {
            float ss = 0.f;
#pragma unroll
            for (int d0 = 0; d0 < 4; ++d0) { const float v = o[d0][r] - lam * ex[crow(r, hi) * 128 + 32 * d0 + r32]; o[d0][r] = v; ss += v * v; }
#pragma unroll
            for (int off = 1; off < 32; off <<= 1) ss += __shfl_xor(ss, off);
            const float rs = rsqrtf(ss * (1.f / 128.f) + 1e-6f);
#pragma unroll
            for (int d0 = 0; d0 < 4; ++d0) ex[crow(r, hi) * 128 + 32 * d0 + r32] = o[d0][r] * rs * g[d0];
        }
        const int c8 = (lane & 15) * 8; bf16_t* op = mix + (size_t)(rowbase + q0 + 32 * wq + (lane >> 4)) * DM + h * 128 + c8; const ALAS float* ep = ex + (lane >> 4) * 128 + c8;
#pragma unroll 1
        for (int it = 0; it < 8; ++it) {
            const f32x4v a = *(const ALAS f32x4v*)ep, bq = *(const ALAS f32x4v*)(ep + 4);
            *(u32x4*)op = (u32x4){cvtpk(a[0], a[1]), cvtpk(a[2], a[3]), cvtpk(bq[0], bq[1]), cvtpk(bq[2], bq[3])};
            op += 4 * DM; ep += 4 * 128;
        }
    }
    AWAIT_BAR(0);
}
#undef AMFMA
#undef AWAIT_BAR
#undef MX3
}

namespace rg {
typedef unsigned short bf16_t;
using bf16x8 = __attribute__((ext_vector_type(8))) short;
using f32x16 = __attribute__((ext_vector_type(16))) float;
using f32x4 = __attribute__((ext_vector_type(4))) float;
using u32x4 = __attribute__((ext_vector_type(4))) unsigned;
typedef float f32x2g __attribute__((ext_vector_type(2)));
constexpr int TC = 64, NCH = SEQ / TC, XROW = 68, WAVE_LDS = 64 * XROW * 4;
__device__ __forceinline__ float sigm(float v) { return __builtin_amdgcn_rcpf(1.f + __expf(-v)); }
__device__ __forceinline__ float lo16(unsigned w) { return __uint_as_float(w << 16); }
__device__ __forceinline__ float hi16(unsigned w) { return __uint_as_float(w & 0xffff0000u); }
template <bool FINAL>
__device__ __forceinline__ void chunk(int b, int c, const bf16_t* __restrict__ P, const bf16_t* __restrict__ WaT, const bf16_t* __restrict__ WiT, const float* ba, const float* bi, const float* Lp,
                                      const float* cw, const float* cb, f32x2g* agg, bf16_t* mix, char* shm) {
    int tid_ = threadIdx.x; asm volatile("" : "+v"(tid_));
    const int tid = tid_, lane = tid & 63, r32 = lane & 31, hi = lane >> 5; const int n = __builtin_amdgcn_readfirstlane(tid >> 6);
    ALAS float* xcs = (ALAS float*)((att::lds_ptr)shm + n * WAVE_LDS);
    const long row0 = (long)b * SEQ + (long)c * TC; const int t0 = c * TC;
    bf16x8 afr[2][4];
#pragma unroll
    for (int tb = 0; tb < 2; ++tb) { const int tok = 32 * tb + r32;
#pragma unroll
        for (int s = 0; s < 4; ++s) { const int chl = 16 * s + 8 * hi, gch = n * 64 + chl;
            f32x4 a0 = *(const f32x4*)(cb + gch), a1 = *(const f32x4*)(cb + gch + 4);
#pragma unroll
            for (int j = 0; j < 4; ++j) {
                if (t0 + tok - 3 + j >= 0) {
                    const u32x4 raw = *(const u32x4*)(P + (row0 + tok - 3 + j) * DIN + PXR + gch);
                    const f32x4 w0 = *(const f32x4*)(cw + j * 512 + gch), w1 = *(const f32x4*)(cw + j * 512 + gch + 4);
                    a0[0] += w0[0] * lo16(raw.x); a0[1] += w0[1] * hi16(raw.x); a0[2] += w0[2] * lo16(raw.y); a0[3] += w0[3] * hi16(raw.y);
                    a1[0] += w1[0] * lo16(raw.z); a1[1] += w1[1] * hi16(raw.z); a1[2] += w1[2] * lo16(raw.w); a1[3] += w1[3] * hi16(raw.w);
                }
            }
            *(ALAS f32x4*)(xcs + tok * XROW + chl) = a0; *(ALAS f32x4*)(xcs + tok * XROW + chl + 4) = a1;
            const u32x4 pk = (u32x4){att::cvtpk(a0[0], a0[1]), att::cvtpk(a0[2], a0[3]), att::cvtpk(a1[0], a1[1]), att::cvtpk(a1[2], a1[3])};
            afr[tb][s] = __builtin_bit_cast(bf16x8, pk);
            __builtin_amdgcn_sched_barrier(0);
        } }
#pragma unroll
    for (int nb = 0; nb < 2; ++nb) {
        const int ch = n * 64 + 32 * nb + r32;
        f32x16 ra[2], ri[2]; ra[0] = f32x16{}; ra[1] = f32x16{}; ri[0] = f32x16{}; ri[1] = f32x16{};
#pragma unroll
        for (int s = 0; s < 4; ++s) {
            const bf16x8 bfa = *(const bf16x8*)(WaT + (size_t)ch * 64 + 16 * s + 8 * hi), bfi = *(const bf16x8*)(WiT + (size_t)ch * 64 + 16 * s + 8 * hi);
#pragma unroll
            for (int tb = 0; tb < 2; ++tb) { ra[tb] = __builtin_amdgcn_mfma_f32_32x32x16_bf16(afr[tb][s], bfa, ra[tb], 0, 0, 0); ri[tb] = __builtin_amdgcn_mfma_f32_32x32x16_bf16(afr[tb][s], bfi, ri[tb], 0, 0, 0); }
        }
        const float bav = ba[ch], biv = bi[ch], c8 = -8.f * log1pf(expf(-Lp[ch]));
#pragma unroll
        for (int tb = 0; tb < 2; ++tb)
#pragma unroll
            for (int r = 0; r < 16; ++r) {
                const float xv = xcs[(32 * tb + att::crow(r, hi)) * XROW + 32 * nb + r32];
                const float rr = sigm(ra[tb][r] + bav), ii = sigm(ri[tb][r] + biv), la = c8 * rr;
                ra[tb][r] = __expf(la); ri[tb][r] = sqrtf(-expm1f(2.f * la)) * (ii * xv);
                if ((r & 3) == 3) __builtin_amdgcn_sched_barrier(0);
            }
        float hc = 0.f, atot = 1.f;
        if (FINAL) { const f32x2g* ag = agg + (size_t)b * NCH * 512 + ch; int cc = 0;
            for (; cc + 8 <= c; cc += 8) { f32x2g g[8];
#pragma unroll
                for (int i = 0; i < 8; ++i) g[i] = ag[(size_t)(cc + i) * 512];
#pragma unroll
                for (int i = 0; i < 8; ++i) hc = g[i].x * hc + g[i].y; }
            for (; cc < c; ++cc) { const f32x2g g = ag[(size_t)cc * 512]; hc = g.x * hc + g.y; } }
#pragma unroll
        for (int tb = 0; tb < 2; ++tb)
#pragma unroll
            for (int g4 = 0; g4 < 4; ++g4) {
                float A0[4], A1[4], U0[4], U1[4], k0[4], k1[4];
#pragma unroll
                for (int i = 0; i < 4; ++i) {
                    auto sa = __builtin_amdgcn_permlane32_swap(__float_as_uint(ra[tb][4 * g4 + i]), __float_as_uint(ra[tb][4 * g4 + i]), false, false);
                    auto su = __builtin_amdgcn_permlane32_swap(__float_as_uint(ri[tb][4 * g4 + i]), __float_as_uint(ri[tb][4 * g4 + i]), false, false);
                    A0[i] = __uint_as_float(sa[0]); A1[i] = __uint_as_float(sa[1]); U0[i] = __uint_as_float(su[0]); U1[i] = __uint_as_float(su[1]);
                }
#pragma unroll
                for (int i = 0; i < 4; ++i) { hc = A0[i] * hc + U0[i]; k0[i] = hc; atot *= A0[i]; }
#pragma unroll
                for (int i = 0; i < 4; ++i) { hc = A1[i] * hc + U1[i]; k1[i] = hc; atot *= A1[i]; }
                if (FINAL) {
#pragma unroll
                    for (int i = 0; i < 4; ++i) xcs[(32 * tb + 8 * g4 + 4 * hi + i) * XROW + 32 * nb + r32] = hi ? k1[i] : k0[i];
                }
                __builtin_amdgcn_sched_barrier(0);
            }
        if (!FINAL) { if (hi == 0) agg[((size_t)b * NCH + c) * 512 + ch] = (f32x2g){atot, hc}; }
    }
    if (FINAL) {
        const int c8 = (lane & 7) * 8; const bf16_t* gp = P + (row0 + (lane >> 3)) * DIN + PGR + n * 64 + c8; bf16_t* mp_ = mix + (row0 + (lane >> 3)) * DM + 512 + n * 64 + c8;
        const ALAS float* hp = xcs + (lane >> 3) * XROW + c8;
#pragma unroll 1
        for (int it = 0; it < 8; ++it) {
            const u32x4 raw = *(const u32x4*)gp; const f32x4 h0 = *(const ALAS f32x4*)hp, h1 = *(const ALAS f32x4*)(hp + 4);
            const float gvv[8] = {lo16(raw.x), hi16(raw.x), lo16(raw.y), hi16(raw.y), lo16(raw.z), hi16(raw.z), lo16(raw.w), hi16(raw.w)};
            const float hv[8] = {h0[0], h0[1], h0[2], h0[3], h1[0], h1[1], h1[2], h1[3]}; float y[8];
#pragma unroll
            for (int e = 0; e < 8; ++e) { const float gv = gvv[e], uu = 0.7978845608028654f * (gv + 0.044715f * gv * gv * gv); y[e] = hv[e] * gv * sigm(2.f * uu); }
            *(u32x4*)mp_ = (u32x4){att::cvtpk(y[0], y[1]), att::cvtpk(y[2], y[3]), att::cvtpk(y[4], y[5]), att::cvtpk(y[6], y[7])};
            gp += 8 * DIN; mp_ += 8 * DM; hp += 8 * XROW;
        }
    }
}
}

constexpr int NWAVES = 8;
constexpr size_t MiB = 1u << 20;
constexpr size_t WS_CTL = 0, CTL_ZERO_BYTES = 1 * MiB;
constexpr size_t WS_MOD = 1 * MiB, WS_LAM = 1 * MiB + 256 * 1024;
constexpr size_t WS_W13A = 2 * MiB, WS_W2A = 13 * MiB, WS_W13B = 19 * MiB, WS_W2B = 30 * MiB, WS_WIN = 36 * MiB, WS_WOUT = 41 * MiB, WS_WAT = 43 * MiB, WS_WIT = 43 * MiB + 512 * 1024;
constexpr size_t WS_H = 48 * MiB;
constexpr size_t WS_U = 112 * MiB;
constexpr size_t WS_MIX = 288 * MiB;
constexpr size_t WS_AGG = 352 * MiB;
constexpr size_t WS_NAIVE = 384 * MiB, WS_END = 512 * MiB;
static_assert(WS_W13A + (size_t)2 * DFF * DM * 2 <= WS_W2A && WS_W2A + (size_t)DM * DFF * 2 <= WS_W13B && WS_W13B + (size_t)2 * DFF * DM * 2 <= WS_W2B && WS_W2B + (size_t)DM * DFF * 2 <= WS_WIN
              && WS_WIN + (size_t)DIN * DM * 2 <= WS_WOUT && WS_WOUT + (size_t)DM * DM * 2 <= WS_WAT && WS_H + (size_t)MTOK * DM * 2 <= WS_U && WS_U + (size_t)MTOK * DFF * 2 <= WS_MIX
              && WS_MIX + (size_t)MTOK * DM * 2 <= WS_AGG, "d_ws map");
constexpr int CW_BAR = 4096;
constexpr int RING_OFF = 0, RING_BYTES = 143360;
constexpr int LDSCTL_OFF = RING_BYTES, MISC_OFF = LDSCTL_OFF + 320;
constexpr int LDS_BYTES = 147456;
static_assert(att::L_END <= RING_BYTES && 8 * rg::WAVE_LDS <= RING_BYTES && pg8::STAGE_BYTES <= RING_BYTES && MISC_OFF + 128 <= LDS_BYTES, "LDS map");

#define GAS __attribute__((address_space(1)))
#define LAS __attribute__((address_space(3)))
typedef unsigned short bf16;
typedef unsigned v4u __attribute__((ext_vector_type(4)));
typedef float f32x4 __attribute__((ext_vector_type(4)));
typedef GAS unsigned gu32;
#define RLX_AGENT __ATOMIC_RELAXED, __HIP_MEMORY_SCOPE_AGENT
#define LDS_WAIT() asm volatile("s_waitcnt lgkmcnt(0)" ::: "memory")
#define VM_WAIT() asm volatile("s_waitcnt vmcnt(0)" ::: "memory")
__device__ __forceinline__ unsigned f2bf(float f) { unsigned u = __builtin_bit_cast(unsigned, f); return (u + 0x7fffu + ((u >> 16) & 1u)) >> 16; }
__device__ __forceinline__ unsigned pk2(float lo, float hi) { return f2bf(lo) | (f2bf(hi) << 16); }
__device__ __forceinline__ float wave_sum(float v) {
#pragma unroll
    for (int o = 1; o < 64; o <<= 1) v += __shfl_xor(v, o);
    return v;
}

#define XB_TMO      128
#define XB_XCNT(j)  (256  + 64 * (j))
#define XB_XSUB(j)  (1280 + 64 * (j))
#define XB_XGEN(j)  (2304 + 64 * (j))
#define XB_TOP      3328
#define XB_TOPGEN   3392
#define XCD_BAR_WORDS 3456
#define XB_SPIN_CAP (1u << 18)

__device__ __forceinline__ unsigned xb_ld(unsigned* p)              { return __hip_atomic_load(p, __ATOMIC_RELAXED, __HIP_MEMORY_SCOPE_AGENT); }
__device__ __forceinline__ unsigned xb_add(unsigned* p, unsigned v) { return __hip_atomic_fetch_add(p, v, __ATOMIC_RELAXED, __HIP_MEMORY_SCOPE_AGENT); }
__device__ __forceinline__ unsigned xb_xcc_id() { return (unsigned)__builtin_amdgcn_s_getreg((3 << 11) | 20) & 0xFu; }
#define XB_SPIN(cond, bar) do { unsigned _sp = 0; while (cond) { __builtin_amdgcn_s_sleep(1); \
    if ((++_sp & 255u) == 0u) { if (xb_ld(&(bar)[XB_TMO])) break; if (_sp > XB_SPIN_CAP) { atomicAdd(&(bar)[XB_TMO], 1u); break; } } } } while (0)

struct XcdBarrier {
    unsigned* bar; unsigned x;
    volatile LAS unsigned* st;
};

__device__ __forceinline__ XcdBarrier xcd_barrier_post(unsigned* bar, volatile LAS unsigned* st) {
    XcdBarrier b; b.bar = bar; b.x = xb_xcc_id(); b.st = st;
    if (threadIdx.x == 0) (void)xb_add(&bar[XB_XCNT(b.x)], 1u);
    return b;
}
__device__ __forceinline__ void xcd_barrier_complete(unsigned* bar, unsigned x, unsigned& nloc, unsigned& nx) {
    const unsigned G = gridDim.x * gridDim.y * gridDim.z;
    unsigned sum, cnt, mine, sp = 0u;
    for (;;) {
        sum = 0u; cnt = 0u; mine = 0u;
#pragma unroll
        for (unsigned j = 0; j < 16; ++j) { const unsigned c = xb_ld(&bar[XB_XCNT(j)]); sum += c; cnt += (c > 0u) ? 1u : 0u; mine = (j == x) ? c : mine; }
        if (sum == G) break;
        __builtin_amdgcn_s_sleep(1);
        if ((++sp & 255u) == 0u) { if (xb_ld(&bar[XB_TMO])) break; if (sp > XB_SPIN_CAP) { atomicAdd(&bar[XB_TMO], 1u); break; } }
    }
    nloc = mine > 0u ? mine : 1u; nx = cnt > 0u ? cnt : 1u;
}

__device__ __forceinline__ void xcd_barrier(const XcdBarrier& b) {
    asm volatile("s_waitcnt vmcnt(0)" ::: "memory");
    __syncthreads();
    if (threadIdx.x == 0) {
        unsigned* bar = b.bar;
        __builtin_amdgcn_s_waitcnt(0);
        unsigned nloc = b.st[0], nx = b.st[1];
        if (nloc == 0u) { xcd_barrier_complete(bar, b.x, nloc, nx); b.st[0] = nloc; b.st[1] = nx; }
        const unsigned old = xb_add(&bar[XB_XSUB(b.x)], 1u);
        const unsigned gen = old / nloc;
        if (old + 1u == (gen + 1u) * nloc) {
            __builtin_amdgcn_fence(__ATOMIC_RELEASE, "agent");
            asm volatile("s_waitcnt vmcnt(0)" ::: "memory");
            const unsigned og = xb_add(&bar[XB_TOP], 1u);
            const unsigned tg = og / nx;
            if (og + 1u == (tg + 1u) * nx) xb_add(&bar[XB_TOPGEN], 1u);
            else XB_SPIN(xb_ld(&bar[XB_TOPGEN]) == tg, bar);
            __builtin_amdgcn_fence(__ATOMIC_ACQUIRE, "agent");
            xb_add(&bar[XB_XGEN(b.x)], 1u);
            asm volatile("s_waitcnt vmcnt(0)" ::: "memory");
        } else {
            XB_SPIN(xb_ld(&bar[XB_XGEN(b.x)]) == gen, bar);
            __builtin_amdgcn_fence(__ATOMIC_ACQUIRE, "agent");
            asm volatile("s_waitcnt vmcnt(0)" ::: "memory");
        }
    }
    __syncthreads();
}


__device__ __forceinline__ void transpose_tile(const float* W, int ldw, int k0, int n0, bf16* WT, int ldt, int drow0, LAS float* scr, int lane) {
#pragma unroll 8
    for (int i = 0; i < 32; ++i) { const int kk = 2 * i + (lane >> 5); scr[kk * 33 + (lane & 31)] = W[(size_t)(k0 + kk) * ldw + n0 + (lane & 31)]; }
    LDS_WAIT(); asm volatile("" ::: "memory");
    const int c = lane & 7;
#pragma unroll
    for (int j = 0; j < 4; ++j) { const int n = (lane >> 3) + 8 * j; const LAS float* s = scr + (8 * c) * 33 + n;
        v4u o; o.x = pk2(s[0 * 33], s[1 * 33]); o.y = pk2(s[2 * 33], s[3 * 33]); o.z = pk2(s[4 * 33], s[5 * 33]); o.w = pk2(s[6 * 33], s[7 * 33]);
        *(GAS v4u*)(WT + (size_t)(drow0 + n) * ldt + k0 + 8 * c) = o; }
    LDS_WAIT(); asm volatile("" ::: "memory");
}
struct Args { const float* in[27]; float* out; unsigned char* ws; int ph_lo, ph_hi, li, pad; };

__device__ __forceinline__ void normmod_row(const float* xrow, const float* g, const float* sh, const float* sc, bf16* orow, int lane) {
    const GAS f32x4* xr = (const GAS f32x4*)xrow + lane;
    f32x4 v[4]; float s2 = 0.f;
#pragma unroll
    for (int j = 0; j < 4; ++j) { v[j] = xr[64 * j]; s2 += (v[j].x * v[j].x + v[j].y * v[j].y) + (v[j].z * v[j].z + v[j].w * v[j].w); }
    const float rstd = rsqrtf(wave_sum(s2) * (1.f / DM) + 1e-6f);
    GAS unsigned long long* o8 = (GAS unsigned long long*)orow + lane;
#pragma unroll
    for (int j = 0; j < 4; ++j) { const f32x4 gg = ((const f32x4*)g)[lane + 64 * j], ss = ((const f32x4*)sc)[lane + 64 * j], hh = ((const f32x4*)sh)[lane + 64 * j];
        const f32x4 y = v[j] * rstd * gg * (ss + 1.f) + hh;
        o8[64 * j] = (unsigned long long)pk2(y.x, y.y) | ((unsigned long long)pk2(y.z, y.w) << 32); }
}
__device__ __forceinline__ void finalnorm_row(float* xrow, const float* g, int lane) {
    GAS f32x4* xr = (GAS f32x4*)xrow + lane;
    f32x4 v[4]; float s2 = 0.f;
#pragma unroll
    for (int j = 0; j < 4; ++j) { v[j] = xr[64 * j]; s2 += (v[j].x * v[j].x + v[j].y * v[j].y) + (v[j].z * v[j].z + v[j].w * v[j].w); }
    const float rstd = rsqrtf(wave_sum(s2) * (1.f / DM) + 1e-6f);
#pragma unroll
    for (int j = 0; j < 4; ++j) xr[64 * j] = v[j] * rstd * ((const f32x4*)g)[lane + 64 * j];
}

constexpr int NPH = 13;
__global__ void __launch_bounds__(NWAVES * 64, 2) mk_fwd(Args args) {
    extern __shared__ __attribute__((aligned(16))) unsigned char lds[];
    LAS unsigned char* const L = (LAS unsigned char*)lds;
    volatile LAS unsigned* const MISC = (volatile LAS unsigned*)(L + MISC_OFF);
    const int tid0 = threadIdx.x, wave = __builtin_amdgcn_readfirstlane(tid0 >> 6);
#define FRESH_TID() int tid = tid0; asm volatile("" : "+v"(tid)); const int lane = tid & 63
    const int G = gridDim.x; const int bx = blockIdx.x; const int vcu = (G % 8 == 0) ? (bx % 8) * (G / 8) + bx / 8 : bx;
    unsigned char* ws = args.ws;
    gu32* ctl = (gu32*)(ws + WS_CTL);
    const float* x = args.in[0]; const float* cnd = args.in[1]; const float* rel_bias = args.in[2]; const float* ada_w = args.in[3]; const float* ada_b = args.in[4]; const float* norm_g = args.in[5];
    const float* subln_g = args.in[14]; const float* conv_w = args.in[15]; const float* conv_b = args.in[16]; const float* gab = args.in[18]; const float* gib = args.in[20]; const float* lru_L = args.in[21];
    const float* final_g = args.in[26];
    float* out = args.out;
    float* mod = (float*)(ws + WS_MOD); float* lamp = (float*)(ws + WS_LAM);
    bf16* W13A = (bf16*)(ws + WS_W13A); bf16* W2A = (bf16*)(ws + WS_W2A); bf16* W13B = (bf16*)(ws + WS_W13B); bf16* W2B = (bf16*)(ws + WS_W2B);
    bf16* WIN = (bf16*)(ws + WS_WIN); bf16* WOUT = (bf16*)(ws + WS_WOUT); bf16* WAT = (bf16*)(ws + WS_WAT); bf16* WIT = (bf16*)(ws + WS_WIT);
    bf16* H = (bf16*)(ws + WS_H); bf16* U = (bf16*)(ws + WS_U); bf16* P = (bf16*)(ws + WS_U); bf16* MIX = (bf16*)(ws + WS_MIX);
    rg::f32x2g* AGG = (rg::f32x2g*)(ws + WS_AGG);
    for (int u = tid0; u < (LDS_BYTES - LDSCTL_OFF) / 4; u += NWAVES * 64) ((LAS unsigned*)(L + LDSCTL_OFF))[u] = 0u;
    __syncthreads();
    const int lo = args.ph_lo, hi = args.ph_hi;
    const bool multi = (hi - lo) > 1;
    XcdBarrier bar; bar.bar = (unsigned*)(ctl + CW_BAR) + args.li * XCD_BAR_WORDS; bar.x = 0; bar.st = nullptr;
    if (multi) bar = xcd_barrier_post((unsigned*)(ctl + CW_BAR) + args.li * XCD_BAR_WORDS, MISC + 8);
#define IN(k) (lo <= (k) && (k) < hi)
#define SEAM(k) do { if (IN(k) && IN((k) + 1)) xcd_barrier(bar); } while (0)
    const int gw = vcu * NWAVES + wave, NGW = G * NWAVES;

    if (IN(0)) {
        FRESH_TID();
        {
            LAS float* ca = (LAS float*)(L + RING_OFF); LAS float* red = ca + BATCH * DM;
            for (int i = tid; i < BATCH * DM; i += NWAVES * 64) { const float v = cnd[i]; ca[i] = v / (1.f + __expf(-v)); }
            __syncthreads();
            for (int cbk = bx; cbk < 256; cbk += G) {
#pragma unroll 1
                for (int cc = 0; cc < 3; ++cc) {
                    const int e0 = 36 * cbk + 12 * cc; float acc[4][12];
#pragma unroll
                    for (int b = 0; b < 4; ++b)
#pragma unroll
                        for (int j = 0; j < 12; ++j) acc[b][j] = 0.f;
#pragma unroll
                    for (int i = 0; i < 2; ++i) { const int d = tid + 512 * i; const f32x4* wp = (const f32x4*)(ada_w + (size_t)d * (NMOD * DM) + e0);
                        const f32x4 w0 = wp[0], w1 = wp[1], w2 = wp[2]; const float w[12] = {w0.x, w0.y, w0.z, w0.w, w1.x, w1.y, w1.z, w1.w, w2.x, w2.y, w2.z, w2.w};
#pragma unroll
                        for (int b = 0; b < 4; ++b) { const float cv = ca[b * DM + d];
#pragma unroll
                            for (int j = 0; j < 12; ++j) acc[b][j] += cv * w[j]; } }
#pragma unroll
                    for (int b = 0; b < 4; ++b)
#pragma unroll
                        for (int j = 0; j < 12; ++j) { const float s = wave_sum(acc[b][j]); if (lane == 0) red[wave * 144 + cc * 48 + b * 12 + j] = s; }
                }
                __syncthreads();
                if (tid < 144) { const int cc = tid / 48, b = (tid % 48) / 12, j = tid % 12, e = 36 * cbk + 12 * cc + j; float s = ada_b[e];
#pragma unroll
                    for (int w = 0; w < 8; ++w) s += red[w * 144 + tid];
                    mod[(size_t)b * NMOD * DM + e] = s; }
                __syncthreads();
            }
            if (bx == 0 && wave == 0) { const float s1 = wave_sum(args.in[10][lane] * args.in[11][lane]), s2 = wave_sum(args.in[12][lane] * args.in[13][lane]); if (lane == 0) lamp[0] = expf(s1) - expf(s2) + 0.2f; }
            __syncthreads();
        }
        {
            LAS float* scr = (LAS float*)(L + RING_OFF + wave * 16384);
            constexpr int I_UP = (DM / 64) * (DFF / 32), I_DN = (DFF / 64) * (DM / 32), I_IN = (DM / 64) * (DIN / 32), I_OUT = (DM / 64) * (DM / 32), I_G = 16;
            constexpr int NITEMS = 4 * I_UP + 2 * I_DN + I_IN + I_OUT + 2 * I_G;
            for (int it = gw; it < NITEMS; it += NGW) {
                int r = it;
                if (r < 4 * I_UP) { const int which = r / I_UP; r -= which * I_UP; const int nblk = DFF / 32, kb = r / nblk, nb = r % nblk, n0 = 32 * nb;
                    const float* W = args.in[which == 0 ? 6 : which == 1 ? 7 : which == 2 ? 23 : 24]; bf16* WT = (which < 2) ? W13A : W13B;
                    transpose_tile(W, DFF, 64 * kb, n0, WT, DM, 256 * (n0 >> 7) + (n0 & 127) + ((which & 1) ? 128 : 0), scr, lane); continue; }
                r -= 4 * I_UP;
                if (r < 2 * I_DN) { const int which = r / I_DN; r -= which * I_DN; const int nblk = DM / 32, kb = r / nblk, nb = r % nblk;
                    transpose_tile(args.in[which ? 25 : 8], DM, 64 * kb, 32 * nb, which ? W2B : W2A, DFF, 32 * nb, scr, lane); continue; }
                r -= 2 * I_DN;
                if (r < I_IN) { const int nblk = DIN / 32, kb = r / nblk, nb = r % nblk; transpose_tile(args.in[9], DIN, 64 * kb, 32 * nb, WIN, DM, 32 * nb, scr, lane); continue; }
                r -= I_IN;
                if (r < I_OUT) { const int nblk = DM / 32, kb = r / nblk, nb = r % nblk; transpose_tile(args.in[22], DM, 64 * kb, 32 * nb, WOUT, DM, 32 * nb, scr, lane); continue; }
                r -= I_OUT;
                { const int which = r / I_G; r -= which * I_G; const int n = r >> 1, nb = r & 1;
                  transpose_tile(args.in[which ? 19 : 17] + n * 4096, 64, 0, 32 * nb, (which ? WIT : WAT) + n * 4096, 64, 32 * nb, scr, lane); }
            }
        }
    }
    SEAM(0);
    if (IN(1)) { FRESH_TID(); for (int m = gw; m < MTOK; m += NGW) { const float* md = mod + (size_t)(m / SEQ) * NMOD * DM; normmod_row(x + (size_t)m * DM, norm_g, md + 0 * DM, md + 1 * DM, H + (size_t)m * DM, lane); } }
    SEAM(1);
    if (IN(2)) { pg8::Gemm g{H, W13A, MTOK, 2 * DFF, DM}; pg8::StaticOrder S; S.init(MTOK, 2 * DFF, G, bx); pg8::EpiSwiglu E{U};
        pg8::gemm_phase<pg8::EpiSwiglu, pg8::StaticOrder, true, true>(L + RING_OFF, g, S, E); }
    SEAM(2);
    if (IN(3)) { pg8::Gemm g{U, W2A, MTOK, DM, DFF}; pg8::StaticOrder S; S.init(MTOK, DM, G, bx); pg8::EpiResid E{x, out, mod + 2 * DM, 0.5f};
        pg8::gemm_phase<pg8::EpiResid, pg8::StaticOrder, true, true>(L + RING_OFF, g, S, E); }
    SEAM(3);
    if (IN(4)) { FRESH_TID(); for (int m = gw; m < MTOK; m += NGW) { const float* md = mod + (size_t)(m / SEQ) * NMOD * DM; normmod_row(out + (size_t)m * DM, norm_g + DM, md + 3 * DM, md + 4 * DM, H + (size_t)m * DM, lane); } }
    SEAM(4);
    if (IN(5)) { pg8::Gemm g{H, WIN, MTOK, DIN, DM}; pg8::StaticOrder S; S.init(MTOK, DIN, G, bx); pg8::EpiProj E{P};
        pg8::gemm_phase<pg8::EpiProj, pg8::StaticOrder, true, true>(L + RING_OFF, g, S, E); }
    SEAM(5);
    if (IN(6)) {
#if MK_STAGE >= 3
        for (int i = 0; i < 2; ++i) { const int idx = (i == 0) ? bx : 511 - bx; if (bx < 256) rg::chunk<false>(idx >> 7, idx & 127, P, WAT, WIT, gab, gib, lru_L, conv_w, conv_b, AGG, MIX, (char*)lds + RING_OFF); }
        LDS_WAIT(); __syncthreads();
#endif
#if MK_STAGE >= 2
        { const float lam = lamp[0]; const int bh = (vcu >> 4) & 15, s = vcu & 15;
          if (vcu < 256) for (int i = 0; i < 4; ++i) { const int qb = (i == 0) ? 63 - s : (i == 1) ? 32 + s : (i == 2) ? 31 - s : s;
              att::unit(bh >> 2, bh & 3, qb, P, MIX, rel_bias, lam, subln_g, (char*)lds + RING_OFF); } }
#endif
    }
    SEAM(6);
    if (IN(7)) {
#if MK_STAGE >= 3
        for (int i = 0; i < 2; ++i) { const int idx = (i == 0) ? bx : 511 - bx; if (bx < 256) rg::chunk<true>(idx >> 7, idx & 127, P, WAT, WIT, gab, gib, lru_L, conv_w, conv_b, AGG, MIX, (char*)lds + RING_OFF); }
        LDS_WAIT(); __syncthreads();
#endif
    }
    SEAM(7);
    if (IN(8)) { pg8::Gemm g{MIX, WOUT, MTOK, DM, DM}; pg8::StaticOrder S; S.init(MTOK, DM, G, bx); pg8::EpiResid E{out, out, mod + 5 * DM, 1.0f};
        pg8::gemm_phase<pg8::EpiResid, pg8::StaticOrder, true, true>(L + RING_OFF, g, S, E); }
    SEAM(8);
    if (IN(9)) { FRESH_TID(); for (int m = gw; m < MTOK; m += NGW) { const float* md = mod + (size_t)(m / SEQ) * NMOD * DM; normmod_row(out + (size_t)m * DM, norm_g + 2 * DM, md + 6 * DM, md + 7 * DM, H + (size_t)m * DM, lane); } }
    SEAM(9);
    if (IN(10)) { pg8::Gemm g{H, W13B, MTOK, 2 * DFF, DM}; pg8::StaticOrder S; S.init(MTOK, 2 * DFF, G, bx); pg8::EpiSwiglu E{U};
        pg8::gemm_phase<pg8::EpiSwiglu, pg8::StaticOrder, true, true>(L + RING_OFF, g, S, E); }
    SEAM(10);
    if (IN(11)) { pg8::Gemm g{U, W2B, MTOK, DM, DFF}; pg8::StaticOrder S; S.init(MTOK, DM, G, bx); pg8::EpiResid E{out, out, mod + 8 * DM, 0.5f};
        pg8::gemm_phase<pg8::EpiResid, pg8::StaticOrder, true, true>(L + RING_OFF, g, S, E); }
    SEAM(11);
    if (IN(12)) { FRESH_TID(); for (int m = gw; m < MTOK; m += NGW) finalnorm_row(out + (size_t)m * DM, final_g, lane); }
#undef IN
#undef SEAM
}

extern "C" void kernel_launch(void* const* d_in, const int* in_sizes, int n_in, void* d_out, int out_size, void* d_ws, size_t ws_size, hipStream_t stream) {
    static int grid = 0;
    if (grid == 0) {
        if (n_in != 27 || in_sizes[0] != MTOK * DM || out_size != MTOK * DM || ws_size < WS_END) { fprintf(stderr, "kernel_launch: unexpected shapes (n_in %d, in0 %d, out %d, ws %zu); nothing launched\n", n_in, n_in > 0 ? in_sizes[0] : -1, out_size, ws_size); grid = -1; return; }
        int dev = 0, cus = 0, per_cu = 0;
        if (hipGetDevice(&dev) != hipSuccess || hipDeviceGetAttribute(&cus, hipDeviceAttributeMultiprocessorCount, dev) != hipSuccess) { grid = -1; return; }
        if (hipFuncSetAttribute((const void*)mk_fwd, hipFuncAttributeMaxDynamicSharedMemorySize, LDS_BYTES) != hipSuccess) { fprintf(stderr, "kernel_launch: hipFuncSetAttribute failed\n"); grid = -1; return; }
        if (hipOccupancyMaxActiveBlocksPerMultiprocessor(&per_cu, (const void*)mk_fwd, NWAVES * 64, LDS_BYTES) != hipSuccess || per_cu < 1) { fprintf(stderr, "kernel_launch: occupancy query says %d blocks per CU\n", per_cu); }
        (void)hipGetLastError();
        grid = cus;
        if (grid != 256) fprintf(stderr, "kernel_launch: %d CUs (built for 256)\n", grid);
    }
    if (grid < 0) return;
    (void)hipMemsetAsync((char*)d_ws + WS_CTL, 0, CTL_ZERO_BYTES, stream);
    Args a{};
    for (int i = 0; i < 27; ++i) a.in[i] = (const float*)d_in[i];
    a.out = (float*)d_out; a.ws = (unsigned char*)d_ws;
#define MK_LAUNCH(lo_, hi_, li_) do { a.ph_lo = (lo_); a.ph_hi = (hi_); a.li = (li_); hipLaunchKernelGGL(mk_fwd, dim3(grid), dim3(NWAVES * 64), LDS_BYTES, stream, a); } while (0)
#if MK_STAGE >= 4
    MK_LAUNCH(0, NPH, 0);
#elif MK_STAGE == 3
    for (int p = 0; p < NPH; ++p) MK_LAUNCH(p, p + 1, 0);
#else
    {
        using namespace nv;
        unsigned char* ws = (unsigned char*)d_ws;
        const bf16_t* P = (const bf16_t*)(ws + WS_U); bf16_t* mix = (bf16_t*)(ws + WS_MIX); const float* lam = (const float*)(ws + WS_LAM);
        float* Opart = (float*)(ws + WS_NAIVE); float* xc = (float*)(ws + WS_NAIVE); float* ub = (float*)(ws + WS_NAIVE + 64 * MiB); float* ab = (float*)(ws + WS_H);
#if MK_STAGE == 1
        MK_LAUNCH(0, 6, 0);
        k_attn<<<dim3(SEQ / 256, 8, BATCH), 256, 0, stream>>>(P, (const float*)d_in[2], Opart);
        k_attn_combine<<<MTOK * 4 / 4, 256, 0, stream>>>(Opart, lam, (const float*)d_in[14], mix);
#else
        MK_LAUNCH(0, 7, 0);
#endif
        k_conv<<<MTOK * 512 / 256, 256, 0, stream>>>(P, (const float*)d_in[15], (const float*)d_in[16], xc);
        k_gates<<<MTOK * 512 / 256, 256, 0, stream>>>(xc, (const float*)d_in[17], (const float*)d_in[18], (const float*)d_in[19], (const float*)d_in[20], (const float*)d_in[21], ab, ub);
        k_scan<<<BATCH * 512 / 64, 64, 0, stream>>>(ab, ub, P, mix);
        MK_LAUNCH(8, NPH, 1);
    }
#endif
}
```

```cpp
#include <hip/hip_runtime.h>
#include <cstdint>
#include <cstdio>
#include <cmath>

#ifndef MK_STAGE
#define MK_STAGE 4
#endif

constexpr int BATCH = 4, SEQ = 8192, DM = 1024, MTOK = BATCH * SEQ, DFF = 2816, DIN = 2560, NMOD = 9;
constexpr int PQ = 0, PK = 512, PV = 1024, PXR = 1536, PGR = 2048;
constexpr float LOG2E = 1.4426950408889634f;
constexpr float QSCALE = 0.125f * LOG2E;

#if MK_STAGE < 3
namespace nv {
constexpr int S = SEQ, D = DM;
typedef unsigned short bf16_t;
__device__ __forceinline__ float bf2f(bf16_t v) { return __uint_as_float(((unsigned)v) << 16); }
__device__ __forceinline__ bf16_t f2bf(float f) { unsigned u = __float_as_uint(f); return (bf16_t)((u + 0x7fffu + ((u >> 16) & 1u)) >> 16); }
__device__ __forceinline__ float sigmoidf_(float v) { return 1.f / (1.f + expf(-v)); }
__device__ __forceinline__ float gelu_tanh(float v) { const float u = 0.7978845608028654f * (v + 0.044715f * v * v * v); return 0.5f * v * (1.f + tanhf(u)); }
__device__ __forceinline__ float wave_sum(float v) {
#pragma unroll
    for (int o = 1; o < 64; o <<= 1) v += __shfl_xor(v, o);
    return v;
}
__device__ __forceinline__ int t5_bucket(int n) { if (n < 16) return n; int l = 16 + (int)(logf((float)n / 16.f) / logf(8.f) * 16.f); return l < 31 ? l : 31; }
__global__ void __launch_bounds__(256) k_attn(const bf16_t* P, const float* rel_bias, float* Opart) {
    const int b = blockIdx.z, m = blockIdx.y, h = m >> 1, i = blockIdx.x * 256 + threadIdx.x;
    __shared__ float tbl[128];
    if (threadIdx.x < 128) tbl[threadIdx.x] = rel_bias[t5_bucket(threadIdx.x) * 8 + m];
    __syncthreads();
    float qv[64];
    const bf16_t* qp = P + ((size_t)(b * S + i)) * DIN + PQ + m * 64;
#pragma unroll
    for (int d = 0; d < 64; ++d) qv[d] = bf2f(qp[d]) * 0.6931471805599453f;
    float acc[128];
#pragma unroll
    for (int d = 0; d < 128; ++d) acc[d] = 0.f;
    float mx = -INFINITY, l = 0.f;
    const int jmax = i | 63;
    for (int j = 0; j <= jmax; ++j) {
        const bf16_t* kr = P + ((size_t)(b * S + j)) * DIN + PK + m * 64;
        const bf16_t* vr = P + ((size_t)(b * S + j)) * DIN + PV + h * 128;
        float s = 0.f;
#pragma unroll
        for (int d = 0; d < 64; ++d) s += qv[d] * bf2f(kr[d]);
        const int rel = i - j;
        s += tbl[rel >= 127 ? 127 : (rel < 0 ? 0 : rel)];
        if (j <= i) {
            if (s > mx) { const float corr = expf(mx - s); l *= corr;
#pragma unroll
                for (int d = 0; d < 128; ++d) acc[d] *= corr;
                mx = s; }
            const float p = expf(s - mx); l += p;
#pragma unroll
            for (int d = 0; d < 128; ++d) acc[d] += p * bf2f(vr[d]);
        }
    }
    const float rl = 1.f / l;
    float* op = Opart + ((size_t)(b * S + i) * 8 + m) * 128;
#pragma unroll
    for (int d = 0; d < 128; ++d) op[d] = acc[d] * rl;
}
__global__ void __launch_bounds__(256) k_attn_combine(const float* Opart, const float* lam, const float* subln_g, bf16_t* mix) {
    const int idx = blockIdx.x * 4 + (threadIdx.x >> 6), lane = threadIdx.x & 63, row = idx >> 2, h = idx & 3;
    const float lm = lam[0];
    const float* o1 = Opart + ((size_t)row * 8 + 2 * h) * 128; const float* o2 = o1 + 128;
    const float v0 = o1[lane] - lm * o2[lane], v1 = o1[lane + 64] - lm * o2[lane + 64];
    const float rstd = rsqrtf(wave_sum(v0 * v0 + v1 * v1) * (1.f / 128.f) + 1e-6f);
    mix[(size_t)row * D + h * 128 + lane] = f2bf(v0 * rstd * subln_g[lane] * 0.8f);
    mix[(size_t)row * D + h * 128 + lane + 64] = f2bf(v1 * rstd * subln_g[lane + 64] * 0.8f);
}
__global__ void __launch_bounds__(256) k_conv(const bf16_t* P, const float* cw, const float* cb, float* xc) {
    const size_t idx = (size_t)blockIdx.x * 256 + threadIdx.x; const int c = idx & 511; const int row = (int)(idx >> 9), t = row % S;
    float a = cb[c];
#pragma unroll
    for (int j = 0; j < 4; ++j) { const int tt = t - 3 + j; if (tt >= 0) a += cw[j * 512 + c] * bf2f(P[(size_t)(row - 3 + j) * DIN + PXR + c]); }
    xc[idx] = a;
}
__global__ void __launch_bounds__(256) k_gates(const float* xc, const float* wa, const float* ba, const float* wi, const float* bi, const float* L, float* aout, float* uout) {
    const size_t idx = (size_t)blockIdx.x * 256 + threadIdx.x; const int c = idx & 511, n = c >> 6, d = c & 63; const size_t row = idx >> 9;
    const float* xb = xc + row * 512 + n * 64; float sa = ba[c], si = bi[c];
    for (int cc = 0; cc < 64; ++cc) { const float xv = xb[cc]; sa += xv * wa[(n * 64 + cc) * 64 + d]; si += xv * wi[(n * 64 + cc) * 64 + d]; }
    const float r = sigmoidf_(sa), ig = sigmoidf_(si);
    const float logsig = -log1pf(expf(-L[c]));
    const float log_a = 8.f * r * logsig;
    aout[idx] = expf(log_a);
    uout[idx] = sqrtf(-expm1f(2.f * log_a)) * (ig * xc[idx]);
}
__global__ void __launch_bounds__(64) k_scan(const float* a, const float* u, const bf16_t* P, bf16_t* mix) {
    const int gc = blockIdx.x * 64 + threadIdx.x, b = gc >> 9, c = gc & 511;
    float h = 0.f;
    for (int t = 0; t < S; ++t) { const size_t o = ((size_t)(b * S + t)) * 512 + c; h = a[o] * h + u[o];
        mix[((size_t)(b * S + t)) * D + 512 + c] = f2bf(h * gelu_tanh(bf2f(P[((size_t)(b * S + t)) * DIN + PGR + c]))); }
}
}
#endif

namespace pg8 {
#define PG8_LAS __attribute__((address_space(3)))
typedef unsigned short bf16_t;
typedef short bf16x8 __attribute__((ext_vector_type(8)));
typedef float f32x4 __attribute__((ext_vector_type(4)));
typedef unsigned u32x4 __attribute__((ext_vector_type(4)));
constexpr int BM = 256, BK = 64, HALF = 128, HTB = HALF * BK * 2  , STAGE_BYTES = 8 * HTB, NXCD = 8, WGM = 8;

__host__ __device__ __forceinline__ int lds_byte(int r, int c) { const int st = (r >> 4) * 2 + (c >> 5), rr = r & 15, cc = c & 31, ob = rr * 64 + cc * 2; return st * 1024 + (ob ^ (((ob >> 9) & 1) << 5)); }
__host__ __device__ __forceinline__ void stage_rc(int b, int& R, int& C) { const int st = b / 1024, sb = b % 1024, swz = sb ^ (((sb >> 9) & 1) << 5); R = (st >> 1) * 16 + swz / 64; C = (st & 1) * 32 + (swz % 64) / 2; }
__host__ __device__ __forceinline__ int perm32(int rho) { const int n = rho >> 4, i = rho & 15; return 8 * (i >> 2) + 4 * n + (i & 3); }

struct Unit { int pm, pn; };
struct Gemm { const bf16_t* A; const bf16_t* Bt; int M, N, K; };

struct StaticOrder {
    int nM, nN, nwg, G, c;
    __host__ __device__ void init(int M, int N, int G_, int c_) { nM = M / BM; nN = N / BM; nwg = nM * nN; G = G_; c = c_; }
    __host__ __device__ bool next(int i, Unit& u) const {
        const long L = (long)i * G + c; if (L >= nwg) return false;
        int wgid = (int)L; { const int q = nwg / NXCD, r = nwg % NXCD, xcd = wgid % NXCD, off = wgid / NXCD; wgid = (xcd < r ? xcd * (q + 1) : r * (q + 1) + (xcd - r) * q) + off; }
        const int nig = WGM * nN, gid = wgid / nig, fm = gid * WGM, gsz = (nM - fm) < WGM ? (nM - fm) : WGM;
        u.pm = fm + ((wgid % nig) % gsz); u.pn = (wgid % nig) / gsz; return true;
    }
    __device__ __forceinline__ void a_ready(const Unit&) const {}
    __device__ __forceinline__ void done(const Unit&) const {}
};

__device__ __forceinline__ unsigned cvt_pk_bf16(float lo, float hi) { unsigned r; asm volatile("v_cvt_pk_bf16_f32 %0, %1, %2" : "=v"(r) : "v"(lo), "v"(hi)); return r; }
__device__ __forceinline__ float fast_silu(float g) { return g * __builtin_amdgcn_rcpf(1.f + __builtin_amdgcn_exp2f(-1.4426950408889634f * g)); }

struct EpiSwiglu {
    static constexpr bool PERM = true, AFTER_DRAIN = false;
    bf16_t* U;
    __device__ __forceinline__ void operator()(const f32x4 (&acc)[2][2][4][2], const Unit& u, int wr, int wc, int fr, int fq) const {
        const int row0 = u.pm * BM + wr * 64 + fr, col0 = u.pn * 128 + wc * 32 + 8 * fq;
#pragma unroll
        for (int ai = 0; ai < 2; ++ai)
#pragma unroll
            for (int m = 0; m < 4; ++m) {
                bf16_t* rowp = U + (size_t)(row0 + ai * HALF + m * 16) * DFF + col0;
                const f32x4 g0 = acc[ai][0][m][0], g1 = acc[ai][0][m][1], u0 = acc[ai][1][m][0], u1 = acc[ai][1][m][1];
                u32x4 w;
                w.x = cvt_pk_bf16(fast_silu(g0[0]) * u0[0], fast_silu(g0[1]) * u0[1]); w.y = cvt_pk_bf16(fast_silu(g0[2]) * u0[2], fast_silu(g0[3]) * u0[3]);
                w.z = cvt_pk_bf16(fast_silu(g1[0]) * u1[0], fast_silu(g1[1]) * u1[1]); w.w = cvt_pk_bf16(fast_silu(g1[2]) * u1[2], fast_silu(g1[3]) * u1[3]);
                *(u32x4*)rowp = w;
            }
    }
};
struct EpiResid {
    static constexpr bool PERM = false, AFTER_DRAIN = false;
    const float* xin; float* xout; const float* gate; float coef;
    __device__ __forceinline__ void operator()(const f32x4 (&acc)[2][2][4][2], const Unit& u, int wr, int wc, int fr, int fq) const {
        const int row0 = u.pm * BM + wr * 64 + fr, col0 = u.pn * BM + wc * 32 + 4 * fq, b = (u.pm * BM) / SEQ;
        f32x4 gv[2][2];
#pragma unroll
        for (int bj = 0; bj < 2; ++bj)
#pragma unroll
            for (int n = 0; n < 2; ++n) gv[bj][n] = *(const f32x4*)(gate + (size_t)b * NMOD * DM + col0 + bj * HALF + n * 16) * coef;
#pragma unroll
        for (int ai = 0; ai < 2; ++ai)
#pragma unroll
            for (int m = 0; m < 4; ++m) { const size_t off = (size_t)(row0 + ai * HALF + m * 16) * DM + col0;
#pragma unroll
                for (int bj = 0; bj < 2; ++bj)
#pragma unroll
                    for (int n = 0; n < 2; ++n) { const f32x4 xi = *(const f32x4*)(xin + off + bj * HALF + n * 16); *(f32x4*)(xout + off + bj * HALF + n * 16) = xi + gv[bj][n] * acc[ai][bj][m][n]; } }
    }
};
struct EpiProj {
    static constexpr bool PERM = true, AFTER_DRAIN = false;
    bf16_t* P;
    __device__ __forceinline__ void operator()(const f32x4 (&acc)[2][2][4][2], const Unit& u, int wr, int wc, int fr, int fq) const {
        const int row0 = u.pm * BM + wr * 64 + fr, col0 = u.pn * BM + wc * 32 + 8 * fq; const float sc = (u.pn < 2) ? QSCALE : 1.f;
#pragma unroll
        for (int ai = 0; ai < 2; ++ai)
#pragma unroll
            for (int m = 0; m < 4; ++m) { bf16_t* rowp = P + (size_t)(row0 + ai * HALF + m * 16) * DIN + col0;
#pragma unroll
                for (int bj = 0; bj < 2; ++bj) { const f32x4 v0 = acc[ai][bj][m][0] * sc, v1 = acc[ai][bj][m][1] * sc; u32x4 w;
                    w.x = cvt_pk_bf16(v0[0], v0[1]); w.y = cvt_pk_bf16(v0[2], v0[3]); w.z = cvt_pk_bf16(v1[0], v1[1]); w.w = cvt_pk_bf16(v1[2], v1[3]);
                    *(u32x4*)(rowp + bj * HALF) = w; } }
    }
};

template <class Epi, class Sched, bool ALIGN_EPI = false, bool SP2 = false>
__device__ __forceinline__ void gemm_phase(PG8_LAS unsigned char* lds, const Gemm g, const Sched& S, const Epi& E) {
    int tid_ = threadIdx.x; asm volatile("" : "+v"(tid_));
    const int tid = tid_, wid = __builtin_amdgcn_readfirstlane(tid >> 6), lane = tid & 63, wr = wid >> 2, wc = wid & 3, fr = lane & 15, fq = lane >> 4;
    const int K = g.K, nt = K / BK;
    unsigned voffA[2], voffB[2];
#pragma unroll
    for (int i = 0; i < 2; ++i) { int R, C; stage_rc(tid * 16 + i * 8192, R, C); const int Rb = Epi::PERM ? ((R & ~31) + perm32(R & 31)) : R;
        voffA[i] = (unsigned)(R * K + C) * 2u; voffB[i] = (unsigned)(Rb * K + C) * 2u; }
    const size_t kstep = (size_t)(BK * 2);
    const size_t hstep = (size_t)HALF * K * 2;
    const size_t tstep = 2 * hstep;
    const unsigned ldsw = (unsigned)wid * 1024u;
    const int aoff = lds_byte(wr * 64 + fr, fq * 8), boff = lds_byte(wc * 32 + fr, fq * 8);
#define PG8_SA(b, h) (((b) * 2 + (h)) * HTB)
#define PG8_SB(b, h) ((4 + (b) * 2 + (h)) * HTB)
#define PG8_STAGE(bufoff, gbase, voff) do { _Pragma("unroll") for (int _i = 0; _i < 2; ++_i) \
        __builtin_amdgcn_global_load_lds((const unsigned*)((const char*)(gbase) + (voff)[_i]), (PG8_LAS unsigned*)(lds + (bufoff) + ldsw + _i * 8192), 16, 0, 0); } while (0)
#define PG8_LDA(dst, b, h) do { _Pragma("unroll") for (int m = 0; m < 4; ++m) _Pragma("unroll") for (int k = 0; k < 2; ++k) dst[m][k] = *(const PG8_LAS bf16x8*)(lds + PG8_SA(b, h) + aoff + m * 2048 + k * 1024); } while (0)
#define PG8_LDB(dst, b, h) do { _Pragma("unroll") for (int n = 0; n < 2; ++n) _Pragma("unroll") for (int k = 0; k < 2; ++k) dst[n][k] = *(const PG8_LAS bf16x8*)(lds + PG8_SB(b, h) + boff + n * 2048 + k * 1024); } while (0)
#define PG8_MMA(ai, bj, At, Bt) do { __builtin_amdgcn_s_setprio(1); _Pragma("unroll") for (int m = 0; m < 4; ++m) _Pragma("unroll") for (int n = 0; n < 2; ++n) _Pragma("unroll") for (int k = 0; k < 2; ++k) \
        acc[ai][bj][m][n] = __builtin_amdgcn_mfma_f32_16x16x32_bf16(Bt[n][k], At[m][k], acc[ai][bj][m][n], 0, 0, 0); __builtin_amdgcn_s_setprio(0); } while (0)
#define PG8_WAIT_V(n) asm volatile("s_waitcnt vmcnt(" #n ")" ::: "memory")
#define PG8_WAIT_L(n) asm volatile("s_waitcnt lgkmcnt(" #n ")" ::: "memory")
#define PG8_BAR __builtin_amdgcn_s_barrier()
#define PG8_SCHED __builtin_amdgcn_sched_barrier(0)
    Unit cur, nxt; int ui = 0;
    if (!S.next(0, cur)) return;
    f32x4 acc[2][2][4][2];
#pragma unroll
    for (int a = 0; a < 2; ++a)
#pragma unroll
        for (int b = 0; b < 2; ++b)
#pragma unroll
            for (int m = 0; m < 4; ++m)
#pragma unroll
                for (int n = 0; n < 2; ++n) acc[a][b][m][n] = (f32x4){0.f, 0.f, 0.f, 0.f};
    bf16x8 At[4][2], B0[2][2], B1[2][2];
    const char* cA = (const char*)g.A + (size_t)cur.pm * tstep; const char* cB = (const char*)g.Bt + (size_t)cur.pn * tstep;
    S.a_ready(cur);
    if constexpr (SP2) {
        PG8_STAGE(PG8_SB(0, 0), cB, voffB); PG8_STAGE(PG8_SB(0, 1), cB + hstep, voffB); PG8_STAGE(PG8_SA(0, 0), cA, voffA); PG8_STAGE(PG8_SA(0, 1), cA + hstep, voffA);
        if (wr == 1) PG8_BAR;
        PG8_WAIT_V(2); PG8_BAR;
        PG8_STAGE(PG8_SB(1, 0), cB + kstep, voffB); PG8_STAGE(PG8_SA(1, 0), cA + kstep, voffA); PG8_STAGE(PG8_SB(1, 1), cB + hstep + kstep, voffB);
        PG8_WAIT_V(6); PG8_BAR;
    } else {
        PG8_STAGE(PG8_SB(0, 0), cB, voffB); PG8_STAGE(PG8_SA(0, 0), cA, voffA); PG8_STAGE(PG8_SB(0, 1), cB + hstep, voffB); PG8_STAGE(PG8_SA(0, 1), cA + hstep, voffA);
        if (wr == 1) PG8_BAR;
        PG8_WAIT_V(4); PG8_BAR;
        PG8_STAGE(PG8_SB(1, 0), cB + kstep, voffB); PG8_STAGE(PG8_SA(1, 0), cA + kstep, voffA); PG8_STAGE(PG8_SB(1, 1), cB + hstep + kstep, voffB);
        PG8_WAIT_V(6); PG8_BAR;
    }
    for (;;) {
        const bool has_next = S.next(ui + 1, nxt);
        const char* nA = has_next ? (const char*)g.A + (size_t)nxt.pm * tstep : cA; const char* nB = has_next ? (const char*)g.Bt + (size_t)nxt.pn * tstep : cB;
        for (int t = 0; t < nt; t += 2) {
            const bool last = (t == nt - 2);
            const char* a1 = cA + (size_t)(t + 1) * kstep;
            const char* a2 = last ? nA : cA + (size_t)(t + 2) * kstep; const char* b2 = last ? nB : cB + (size_t)(t + 2) * kstep;
            const char* a3 = a2 + kstep; const char* b3 = b2 + kstep;
            if (last && has_next) S.a_ready(nxt);
            if constexpr (SP2) {
            PG8_LDB(B0, 0, 0); PG8_LDB(B1, 0, 1); PG8_SCHED; PG8_LDA(At, 0, 0); PG8_STAGE(PG8_SA(1, 1), a1 + hstep, voffA);
            PG8_WAIT_V(8); PG8_WAIT_L(0); PG8_BAR; PG8_MMA(0, 0, At, B0); PG8_MMA(0, 1, At, B1); PG8_BAR; PG8_SCHED;
            PG8_LDA(At, 0, 1); PG8_STAGE(PG8_SB(0, 0), b2, voffB); PG8_STAGE(PG8_SB(0, 1), b2 + hstep, voffB); PG8_STAGE(PG8_SA(0, 0), a2, voffA);
            PG8_WAIT_V(8); PG8_WAIT_L(0); PG8_BAR; PG8_MMA(1, 0, At, B0); PG8_MMA(1, 1, At, B1); PG8_BAR; PG8_SCHED;
            PG8_LDB(B0, 1, 0); PG8_LDB(B1, 1, 1); PG8_SCHED; PG8_LDA(At, 1, 0); PG8_STAGE(PG8_SA(0, 1), a2 + hstep, voffA);
            PG8_WAIT_V(8); PG8_WAIT_L(0); PG8_BAR; PG8_MMA(0, 0, At, B0); PG8_MMA(0, 1, At, B1); PG8_BAR; PG8_SCHED;
            PG8_LDA(At, 1, 1); PG8_STAGE(PG8_SB(1, 0), b3, voffB); PG8_STAGE(PG8_SB(1, 1), b3 + hstep, voffB); PG8_STAGE(PG8_SA(1, 0), a3, voffA);
            PG8_WAIT_V(8); PG8_WAIT_L(0); PG8_BAR; PG8_MMA(1, 0, At, B0); PG8_MMA(1, 1, At, B1); PG8_BAR; PG8_SCHED;
            } else {
            PG8_LDB(B0, 0, 0); PG8_SCHED; PG8_LDA(At, 0, 0); PG8_STAGE(PG8_SA(1, 1), a1 + hstep, voffA);
            PG8_WAIT_L(8); PG8_BAR; PG8_WAIT_L(0); PG8_MMA(0, 0, At, B0); PG8_BAR; PG8_SCHED;
            PG8_LDB(B1, 0, 1); PG8_STAGE(PG8_SB(0, 0), b2, voffB);
            PG8_BAR; PG8_WAIT_L(0); PG8_MMA(0, 1, At, B1); PG8_BAR;
            PG8_LDA(At, 0, 1); PG8_STAGE(PG8_SA(0, 0), a2, voffA);
            PG8_BAR; PG8_WAIT_L(0); PG8_MMA(1, 0, At, B0); PG8_BAR; PG8_SCHED;
            PG8_STAGE(PG8_SB(0, 1), b2 + hstep, voffB);
            PG8_WAIT_V(6); PG8_BAR; PG8_MMA(1, 1, At, B1); PG8_BAR;
            PG8_LDB(B0, 1, 0); PG8_SCHED; PG8_LDA(At, 1, 0); PG8_STAGE(PG8_SA(0, 1), a2 + hstep, voffA);
            PG8_WAIT_L(8); PG8_BAR; PG8_WAIT_L(0); PG8_MMA(0, 0, At, B0); PG8_BAR; PG8_SCHED;
            PG8_LDB(B1, 1, 1); PG8_STAGE(PG8_SB(1, 0), b3, voffB);
            PG8_BAR; PG8_WAIT_L(0); PG8_MMA(0, 1, At, B1); PG8_BAR;
            PG8_LDA(At, 1, 1); PG8_STAGE(PG8_SA(1, 0), a3, voffA);
            PG8_BAR; PG8_WAIT_L(0); PG8_MMA(1, 0, At, B0); PG8_BAR; PG8_SCHED;
            PG8_STAGE(PG8_SB(1, 1), b3 + hstep, voffB);
            PG8_WAIT_V(6); PG8_BAR; PG8_MMA(1, 1, At, B1); PG8_BAR;
            }
        }
        if constexpr (ALIGN_EPI) { if (wr == 0) PG8_BAR; }
        if constexpr (!Epi::AFTER_DRAIN) { E(acc, cur, wr, wc, fr, fq); S.done(cur); }
        if (!has_next) break;
#pragma unroll
        for (int a = 0; a < 2; ++a)
#pragma unroll
            for (int b = 0; b < 2; ++b)
#pragma unroll
                for (int m = 0; m < 4; ++m)
#pragma unroll
                    for (int n = 0; n < 2; ++n) acc[a][b][m][n] = (f32x4){0.f, 0.f, 0.f, 0.f};
        cur = nxt; cA = nA; cB = nB; ++ui;
        if constexpr (ALIGN_EPI) { if (wr == 1) PG8_BAR; }
    }
    PG8_WAIT_V(0);
    if constexpr (!ALIGN_EPI) { if (wr == 0) PG8_BAR; }
    PG8_BAR;
    if constexpr (Epi::AFTER_DRAIN) { E.fused(acc, cur, wr, wc, fr, fq, lds, wid, lane); S.done(cur); }
#undef PG8_SA
#undef PG8_SB
#undef PG8_STAGE
#undef PG8_LDA
#undef PG8_LDB
#undef PG8_MMA
#undef PG8_WAIT_V
#undef PG8_WAIT_L
#undef PG8_BAR
#undef PG8_SCHED
}
}

namespace att {
typedef unsigned short bf16_t;
using bf16x8 = __attribute__((ext_vector_type(8))) short;
using s16x4 = __attribute__((ext_vector_type(4))) short;
using f32x16 = __attribute__((ext_vector_type(16))) float;
using u32x4 = __attribute__((ext_vector_type(4))) unsigned;
using f32x4v = __attribute__((ext_vector_type(4))) float;
#define ALAS __attribute__((address_space(3)))
typedef ALAS const char* lds_cptr;
typedef ALAS char* lds_ptr;
typedef short v4i16_t __attribute__((ext_vector_type(4)));
constexpr int QB = 128, KVBLK = 64, NQB = SEQ / QB;
constexpr int KSLOT = 16384, NSLOT = 3, TBLN = 384;
constexpr int L_K = 0, L_V = NSLOT * KSLOT, L_TBL = 2 * NSLOT * KSLOT, L_WSF = L_TBL + 2 * TBLN * 4, L_Q = L_WSF + 8 * 64 * 4, L_END = L_Q + 8 * 4096;
constexpr float THR = 8.f;
#define AMFMA(a, b, c) __builtin_amdgcn_mfma_f32_32x32x16_bf16(a, b, c, 0, 0, 0)
#define AWAIT_BAR(N) asm volatile("s_waitcnt vmcnt(" #N ") lgkmcnt(0)\n\ts_barrier" ::: "memory")
__device__ __forceinline__ int crow(int r, int hi) { return (r & 3) + 8 * (r >> 2) + 4 * hi; }
__device__ __forceinline__ void glds16(const void* gsrc, unsigned lds_dst) { unsigned keep;
    asm volatile("s_mov_b32 %0, m0\n\ts_mov_b32 m0, %2\n\ts_nop 0\n\tglobal_load_lds_dwordx4 %1, off\n\ts_mov_b32 m0, %0" : "=&s"(keep) : "v"(gsrc), "s"(lds_dst) : "memory"); }
__device__ __forceinline__ s16x4 vtr(lds_cptr p) { return __builtin_bit_cast(s16x4, __builtin_amdgcn_ds_read_tr16_b64_v4i16((ALAS v4i16_t*)p)); }
__device__ __forceinline__ unsigned cvtpk(float lo, float hi) { typedef float f2 __attribute__((ext_vector_type(2))); typedef __bf16 b2 __attribute__((ext_vector_type(2))); f2 v = {lo, hi}; b2 b = __builtin_convertvector(v, b2); return __builtin_bit_cast(unsigned, b); }
__device__ __forceinline__ bf16_t f2bf(float f) { unsigned u = __float_as_uint(f); return (bf16_t)((u + 0x7fffu + ((u >> 16) & 1u)) >> 16); }
__device__ __forceinline__ int t5_bucket(int n) { if (n < 16) return n; int l = 16 + (int)(logf((float)n / 16.f) / logf(8.f) * 16.f); return l < 31 ? l : 31; }
#define MX3(a, b, c) __builtin_fmaxf(__builtin_fmaxf((a), (b)), (c))
__device__ __forceinline__ float rowmax(const f32x16& p0, const f32x16& p1) {
    float a = MX3(p0[0], p0[1], p1[0]), b = MX3(p0[2], p0[3], p1[1]); a = MX3(a, p1[2], p1[3]);
#pragma unroll
    for (int r = 4; r < 16; r += 4) { a = MX3(a, p0[r], p0[r + 1]); b = MX3(b, p0[r + 2], p0[r + 3]); a = MX3(a, p1[r], p1[r + 1]); b = MX3(b, p1[r + 2], p1[r + 3]); }
    float m = __builtin_fmaxf(a, b); auto rr = __builtin_amdgcn_permlane32_swap(__float_as_uint(m), __float_as_uint(m), false, false);
    return __builtin_fmaxf(__uint_as_float(rr[0]), __uint_as_float(rr[1])); }

#ifndef ATT_VAR_A
#define ATT_VAR_A 1
#endif
#ifndef ATT_VAR_D
#define ATT_VAR_D 1
#endif
#ifndef ATT_LAGGED
#define ATT_LAGGED 1
#endif
#if ATT_LAGGED
template <bool BAND>
__device__ __forceinline__ void tile(f32x16 (&o)[4], float& mhat, float& lreg, f32x16& negm, lds_cptr qp, lds_cptr kp, lds_cptr vp, const ALAS float* tb, ALAS float* wsf, bool first, float bfar, int r32, int hi) {
    bf16x8 kf[8], qr[4];
#pragma unroll
    for (int d0 = 0; d0 < 4; ++d0) qr[d0] = *(const ALAS bf16x8*)(qp + d0 * 1024);
#pragma unroll
    for (int d0 = 0; d0 < 4; ++d0) { kf[2 * d0] = *(const ALAS bf16x8*)(kp + d0 * 2048); kf[2 * d0 + 1] = *(const ALAS bf16x8*)(kp + d0 * 2048 + 512); }
#if ATT_VAR_A
    f32x16 C0 = AMFMA(kf[0], qr[0], negm), C1 = AMFMA(kf[1], qr[0], negm);
#pragma unroll
    for (int d0 = 1; d0 < 4; ++d0) { C0 = AMFMA(kf[2 * d0], qr[d0], C0); C1 = AMFMA(kf[2 * d0 + 1], qr[d0], C1); }
#else
    f32x16 C0 = AMFMA(kf[0], qr[0], negm);
#pragma unroll
    for (int d0 = 1; d0 < 4; ++d0) C0 = AMFMA(kf[2 * d0], qr[d0], C0);
    f32x16 C1 = AMFMA(kf[1], qr[0], negm);
#pragma unroll
    for (int d0 = 1; d0 < 4; ++d0) C1 = AMFMA(kf[2 * d0 + 1], qr[d0], C1);
#endif
    if (BAND) {
#pragma unroll
        for (int r = 0; r < 16; ++r) { const int c = (r & 3) + 8 * (r >> 2); C0[r] += tb[-c]; C1[r] += tb[-c - 32]; }
    }
    if (first) {
        const float rm = rowmax(C0, C1); mhat = rm;
#pragma unroll
        for (int r = 0; r < 16; ++r) { C0[r] -= rm; C1[r] -= rm; negm[r] = bfar - mhat; }
    }
    u32x4 pw[4]; float sacc = 0.f;
#pragma unroll
    for (int r = 0; r < 16; ++r) { C0[r] = __builtin_amdgcn_exp2f(C0[r]); sacc += C0[r]; }
    pw[0] = (u32x4){cvtpk(C0[0], C0[1]), cvtpk(C0[2], C0[3]), cvtpk(C0[4], C0[5]), cvtpk(C0[6], C0[7])};
    pw[1] = (u32x4){cvtpk(C0[8], C0[9]), cvtpk(C0[10], C0[11]), cvtpk(C0[12], C0[13]), cvtpk(C0[14], C0[15])};
#pragma unroll
    for (int r = 0; r < 16; ++r) { C1[r] = __builtin_amdgcn_exp2f(C1[r]); sacc += C1[r]; }
    pw[2] = (u32x4){cvtpk(C1[0], C1[1]), cvtpk(C1[2], C1[3]), cvtpk(C1[4], C1[5]), cvtpk(C1[6], C1[7])};
    pw[3] = (u32x4){cvtpk(C1[8], C1[9]), cvtpk(C1[10], C1[11]), cvtpk(C1[12], C1[13]), cvtpk(C1[14], C1[15])};
    lreg += sacc;
    const float pm = rowmax(C0, C1);
#if ATT_VAR_D
#pragma unroll
    for (int d0 = 0; d0 < 4; ++d0)
#pragma unroll
        for (int s = 0; s < 4; ++s) {
#else
#pragma unroll
    for (int s = 0; s < 4; ++s)
#pragma unroll
        for (int d0 = 0; d0 < 4; ++d0) {
#endif
            const s16x4 lo = vtr(vp + d0 * 4096 + s * 1024), hh = vtr(vp + d0 * 4096 + s * 1024 + 512);
            const bf16x8 vf = (bf16x8){lo[0], lo[1], lo[2], lo[3], hh[0], hh[1], hh[2], hh[3]};
            o[d0] = AMFMA(__builtin_bit_cast(bf16x8, pw[s]), vf, o[d0]);
        }
    if (__any(pm > 256.f)) {
        const float dl = __builtin_fmaxf(__builtin_amdgcn_logf(pm), 0.f); mhat += dl;
        const float f = __builtin_amdgcn_exp2f(-dl); lreg *= f;
#pragma unroll
        for (int r = 0; r < 16; ++r) negm[r] = bfar - mhat;
        if (hi == 0) wsf[r32] = f;
#pragma unroll
        for (int r = 0; r < 16; ++r) { const float fr = wsf[crow(r, hi)];
#pragma unroll
            for (int d0 = 0; d0 < 4; ++d0) o[d0][r] *= fr; }
    }
}

#else
template <bool BAND>
__device__ __forceinline__ void tile(f32x16 (&o)[4], float& mhat, float& lreg, f32x16& negm, lds_cptr qp, lds_cptr kp, lds_cptr vp, const ALAS float* tb, ALAS float* wsf, bool first, float bfar, int r32, int hi) {
    bf16x8 kf[8], qr[4];
#pragma unroll
    for (int d0 = 0; d0 < 4; ++d0) qr[d0] = *(const ALAS bf16x8*)(qp + d0 * 1024);
#pragma unroll
    for (int d0 = 0; d0 < 4; ++d0) { kf[2 * d0] = *(const ALAS bf16x8*)(kp + d0 * 2048); kf[2 * d0 + 1] = *(const ALAS bf16x8*)(kp + d0 * 2048 + 512); }
    f32x16 C0 = AMFMA(kf[0], qr[0], negm), C1 = AMFMA(kf[1], qr[0], negm);
#pragma unroll
    for (int d0 = 1; d0 < 4; ++d0) { C0 = AMFMA(kf[2 * d0], qr[d0], C0); C1 = AMFMA(kf[2 * d0 + 1], qr[d0], C1); }
    if (BAND) {
#pragma unroll
        for (int r = 0; r < 16; ++r) { const int c = (r & 3) + 8 * (r >> 2); C0[r] += tb[-c]; C1[r] += tb[-c - 32]; }
    }
    const float rm = rowmax(C0, C1);
    if (first) {
        mhat = rm;
#pragma unroll
        for (int r = 0; r < 16; ++r) { C0[r] -= rm; C1[r] -= rm; negm[r] = bfar - mhat; }
    } else if (__any(rm > THR)) {
        const float dl = __builtin_fmaxf(rm, 0.f); mhat += dl;
#pragma unroll
        for (int r = 0; r < 16; ++r) { C0[r] -= dl; C1[r] -= dl; negm[r] = bfar - mhat; }
        const float f = __builtin_amdgcn_exp2f(-dl); lreg *= f;
        if (hi == 0) wsf[r32] = f;
#pragma unroll
        for (int r = 0; r < 16; ++r) { const float fr = wsf[crow(r, hi)];
#pragma unroll
            for (int d0 = 0; d0 < 4; ++d0) o[d0][r] *= fr; }
    }
    float sacc = 0.f;
#pragma unroll
    for (int r = 0; r < 16; ++r) { C0[r] = __builtin_amdgcn_exp2f(C0[r]); C1[r] = __builtin_amdgcn_exp2f(C1[r]); sacc += C0[r] + C1[r]; }
    lreg += sacc;
    u32x4 pw[4];
    pw[0] = (u32x4){cvtpk(C0[0], C0[1]), cvtpk(C0[2], C0[3]), cvtpk(C0[4], C0[5]), cvtpk(C0[6], C0[7])};
    pw[1] = (u32x4){cvtpk(C0[8], C0[9]), cvtpk(C0[10], C0[11]), cvtpk(C0[12], C0[13]), cvtpk(C0[14], C0[15])};
    pw[2] = (u32x4){cvtpk(C1[0], C1[1]), cvtpk(C1[2], C1[3]), cvtpk(C1[4], C1[5]), cvtpk(C1[6], C1[7])};
    pw[3] = (u32x4){cvtpk(C1[8], C1[9]), cvtpk(C1[10], C1[11]), cvtpk(C1[12], C1[13]), cvtpk(C1[14], C1[15])};
#pragma unroll
    for (int d0 = 0; d0 < 4; ++d0)
#pragma unroll
        for (int s = 0; s < 4; ++s) {
            const s16x4 lo = vtr(vp + d0 * 4096 + s * 1024), hh = vtr(vp + d0 * 4096 + s * 1024 + 512);
            const bf16x8 vf = (bf16x8){lo[0], lo[1], lo[2], lo[3], hh[0], hh[1], hh[2], hh[3]};
            o[d0] = AMFMA(__builtin_bit_cast(bf16x8, pw[s]), vf, o[d0]);
            if (s == 3) __builtin_amdgcn_sched_barrier(0);
        }
}

#endif
__device__ __forceinline__ void unit(int b, int h, int qb, const bf16_t* __restrict__ P, bf16_t* mix, const float* relb, float lam, const float* subln, char* shm) {
    int tid_ = threadIdx.x; asm volatile("" : "+v"(tid_));
    const int tid = tid_, lane = tid & 63, r32 = lane & 31, hi = lane >> 5; const int wid = __builtin_amdgcn_readfirstlane(tid >> 6), mp = wid >> 2, wq = wid & 3;
    const long rowbase = (long)b * SEQ; const int q0 = qb * QB, NT = 2 * qb + 2;
    const unsigned lds0 = (unsigned)(uintptr_t)shm; const lds_ptr shm3 = (lds_ptr)shm;
    ALAS float* tbl = (ALAS float*)(shm3 + L_TBL); ALAS float* wsf = (ALAS float*)(shm3 + L_WSF) + wid * 64;
    for (int i = tid; i < 2 * TBLN; i += 512) { const int mm = i / TBLN, rel = (i - mm * TBLN) - 128; float v = -INFINITY;
        if (rel >= 0) v = (relb[t5_bucket(rel) * 8 + 2 * h + mm] - relb[31 * 8 + 2 * h + mm]) * LOG2E;
        tbl[i] = v; }
    const float bfar = relb[31 * 8 + 2 * h + mp] * LOG2E;
    const bf16_t* Pb = P + rowbase * DIN;
    const bf16_t* ksrc = Pb + (long)lane * DIN + PK + (2 * h) * 64 + wid * 8;
    const bf16_t* vsrc = Pb + (long)(16 * (wid & 3) + (lane >> 2)) * DIN + PV + h * 128 + (wid >> 2) * 32 + (lane & 3) * 8;
    const unsigned kdst = lds0 + L_K + wid * 1024, vdst = lds0 + L_V + wid * 1024;
#define ADMA(t, slot) do { const long go_ = (long)(t) * KVBLK * DIN; \
        glds16(ksrc + go_, (unsigned)__builtin_amdgcn_readfirstlane(kdst + (slot))); glds16(ksrc + go_ + 64, (unsigned)__builtin_amdgcn_readfirstlane(kdst + (slot) + 8192)); \
        glds16(vsrc + go_, (unsigned)__builtin_amdgcn_readfirstlane(vdst + (slot))); glds16(vsrc + go_ + 64, (unsigned)__builtin_amdgcn_readfirstlane(vdst + (slot) + 8192)); } while (0)
    const lds_cptr kp0 = (lds_cptr)shm3 + L_K + mp * 8192 + hi * 1024 + r32 * 16;
    const lds_cptr vp0 = (lds_cptr)shm3 + L_V + ((lane >> 4) & 1) * 32 + (lane & 3) * 8 + (4 * hi + ((lane & 15) >> 2)) * 64;
    const lds_ptr qp0 = shm3 + L_Q + wid * 4096 + lane * 16;
    { const bf16_t* Qw = Pb + (long)(q0 + 32 * wq + r32) * DIN + PQ + (2 * h + mp) * 64 + hi * 8;
#pragma unroll
      for (int d0 = 0; d0 < 4; ++d0) *(ALAS bf16x8*)(qp0 + d0 * 1024) = *reinterpret_cast<const bf16x8*>(Qw + d0 * 16); }
    ADMA(0, 0); ADMA(1, KSLOT);
    f32x16 o[4]; o[0] = f32x16{}; o[1] = f32x16{}; o[2] = f32x16{}; o[3] = f32x16{};
    float mhat = 0.f, lreg = 0.f; f32x16 negm;
#pragma unroll
    for (int r = 0; r < 16; ++r) negm[r] = bfar;
    const int qabs = q0 + 32 * wq + r32;
    const ALAS float* tbq = tbl + mp * TBLN + (qabs + 128 - 4 * hi);
    int sl = 0, sln = 2 * KSLOT;
    const int tband = NT > 4 ? NT - 4 : 0;
    int t = 0;
    for (; t < tband; ++t) {
        AWAIT_BAR(4);
        ADMA(t + 2, sln);
        tile<false>(o, mhat, lreg, negm, (lds_cptr)qp0, kp0 + sl, vp0 + sl, tbq, wsf, t == 0, bfar, r32, hi);
        sl = (sl == 2 * KSLOT) ? 0 : sl + KSLOT; sln = (sln == 2 * KSLOT) ? 0 : sln + KSLOT;
    }
    for (; t < NT; ++t) {
        if (t + 1 < NT) { AWAIT_BAR(4); } else { AWAIT_BAR(0); }
        if (t + 2 < NT) ADMA(t + 2, sln);
        tile<true>(o, mhat, lreg, negm, (lds_cptr)qp0, kp0 + sl, vp0 + sl, tbq - 64 * t, wsf, t == 0, bfar, r32, hi);
        sl = (sl == 2 * KSLOT) ? 0 : sl + KSLOT; sln = (sln == 2 * KSLOT) ? 0 : sln + KSLOT;
    }
#undef ADMA
    { auto rr = __builtin_amdgcn_permlane32_swap(__float_as_uint(lreg), __float_as_uint(lreg), false, false); lreg = __uint_as_float(rr[0]) + __uint_as_float(rr[1]); }
    if (hi == 0) wsf[32 + r32] = lreg;
#pragma unroll
    for (int r = 0; r < 16; ++r) { const float rl = __builtin_amdgcn_rcpf(wsf[32 + crow(r, hi)]);
#pragma unroll
        for (int d0 = 0; d0 < 4; ++d0) o[d0][r] *= rl; }
    AWAIT_BAR(0);
    ALAS float* ex = (ALAS float*)shm3 + wq * 4096;
    if (mp == 1) {
#pragma unroll
        for (int r = 0; r < 16; ++r)
#pragma unroll
            for (int d0 = 0; d0 < 4; ++d0) ex[crow(r, hi) * 128 + 32 * d0 + r32] = o[d0][r];
    }
    AWAIT_BAR(0);
    if (mp == 0) {
        float g[4];
#pragma unroll
        for (int d0 = 0; d0 < 4; ++d0) g[d0] = subln[32 * d0 + r32] * 0.8f;
#pragma unroll
        for (int r = 0; r < 16; ++r) {
            float ss = 0.f;
#pragma unroll
            for (int d0 = 0; d0 < 4; ++d0) { const float v = o[d0][r] - lam * ex[crow(r, hi) * 128 + 32 * d0 + r32]; o[d0][r] = v; ss += v * v; }
#pragma unroll
            for (int off = 1; off < 32; off <<= 1) ss += __shfl_xor(ss, off);
            const float rs = rsqrtf(ss * (1.f / 128.f) + 1e-6f);
#pragma unroll
            for (int d0 = 0; d0 < 4; ++d0) ex[crow(r, hi) * 128 + 32 * d0 + r32] = o[d0][r] * rs * g[d0];
        }
        const int c8 = (lane & 15) * 8; bf16_t* op = mix + (size_t)(rowbase + q0 + 32 * wq + (lane >> 4)) * DM + h * 128 + c8; const ALAS float* ep = ex + (lane >> 4) * 128 + c8;
#pragma unroll 1
        for (int it = 0; it < 8; ++it) {
            const f32x4v a = *(const ALAS f32x4v*)ep, bq = *(const ALAS f32x4v*)(ep + 4);
            *(u32x4*)op = (u32x4){cvtpk(a[0], a[1]), cvtpk(a[2], a[3]), cvtpk(bq[0], bq[1]), cvtpk(bq[2], bq[3])};
            op += 4 * DM; ep += 4 * 128;
        }
    }
    AWAIT_BAR(0);
}
#undef AMFMA
#undef AWAIT_BAR
#undef MX3
}

namespace rg {
typedef unsigned short bf16_t;
using bf16x8 = __attribute__((ext_vector_type(8))) short;
using f32x16 = __attribute__((ext_vector_type(16))) float;
using f32x4 = __attribute__((ext_vector_type(4))) float;
using u32x4 = __attribute__((ext_vector_type(4))) unsigned;
typedef float f32x2g __attribute__((ext_vector_type(2)));
constexpr int TC = 64, NCH = SEQ / TC, XROW = 68, WAVE_LDS = 64 * XROW * 4;
__device__ __forceinline__ float sigm(float v) { return __builtin_amdgcn_rcpf(1.f + __expf(-v)); }
__device__ __forceinline__ float lo16(unsigned w) { return __uint_as_float(w << 16); }
__device__ __forceinline__ float hi16(unsigned w) { return __uint_as_float(w & 0xffff0000u); }
template <bool FINAL>
__device__ __forceinline__ void chunk(int b, int c, const bf16_t* __restrict__ P, const bf16_t* __restrict__ WaT, const bf16_t* __restrict__ WiT, const float* ba, const float* bi, const float* Lp,
                                      const float* cw, const float* cb, f32x2g* agg, bf16_t* mix, char* shm) {
    int tid_ = threadIdx.x; asm volatile("" : "+v"(tid_));
    const int tid = tid_, lane = tid & 63, r32 = lane & 31, hi = lane >> 5; const int n = __builtin_amdgcn_readfirstlane(tid >> 6);
    ALAS float* xcs = (ALAS float*)((att::lds_ptr)shm + n * WAVE_LDS);
    const long row0 = (long)b * SEQ + (long)c * TC; const int t0 = c * TC;
    bf16x8 afr[2][4];
#pragma unroll
    for (int tb = 0; tb < 2; ++tb) { const int tok = 32 * tb + r32;
#pragma unroll
        for (int s = 0; s < 4; ++s) { const int chl = 16 * s + 8 * hi, gch = n * 64 + chl;
            f32x4 a0 = *(const f32x4*)(cb + gch), a1 = *(const f32x4*)(cb + gch + 4);
#pragma unroll
            for (int j = 0; j < 4; ++j) {
                if (t0 + tok - 3 + j >= 0) {
                    const u32x4 raw = *(const u32x4*)(P + (row0 + tok - 3 + j) * DIN + PXR + gch);
                    const f32x4 w0 = *(const f32x4*)(cw + j * 512 + gch), w1 = *(const f32x4*)(cw + j * 512 + gch + 4);
                    a0[0] += w0[0] * lo16(raw.x); a0[1] += w0[1] * hi16(raw.x); a0[2] += w0[2] * lo16(raw.y); a0[3] += w0[3] * hi16(raw.y);
                    a1[0] += w1[0] * lo16(raw.z); a1[1] += w1[1] * hi16(raw.z); a1[2] += w1[2] * lo16(raw.w); a1[3] += w1[3] * hi16(raw.w);
                }
            }
            *(ALAS f32x4*)(xcs + tok * XROW + chl) = a0; *(ALAS f32x4*)(xcs + tok * XROW + chl + 4) = a1;
            const u32x4 pk = (u32x4){att::cvtpk(a0[0], a0[1]), att::cvtpk(a0[2], a0[3]), att::cvtpk(a1[0], a1[1]), att::cvtpk(a1[2], a1[3])};
            afr[tb][s] = __builtin_bit_cast(bf16x8, pk);
            if (s == 3) __builtin_amdgcn_sched_barrier(0);
        } }
#pragma unroll
    for (int nb = 0; nb < 2; ++nb) {
        const int ch = n * 64 + 32 * nb + r32;
        f32x16 ra[2], ri[2]; ra[0] = f32x16{}; ra[1] = f32x16{}; ri[0] = f32x16{}; ri[1] = f32x16{};
#pragma unroll
        for (int s = 0; s < 4; ++s) {
            const bf16x8 bfa = *(const bf16x8*)(WaT + (size_t)ch * 64 + 16 * s + 8 * hi), bfi = *(const bf16x8*)(WiT + (size_t)ch * 64 + 16 * s + 8 * hi);
#pragma unroll
            for (int tb = 0; tb < 2; ++tb) { ra[tb] = __builtin_amdgcn_mfma_f32_32x32x16_bf16(afr[tb][s], bfa, ra[tb], 0, 0, 0); ri[tb] = __builtin_amdgcn_mfma_f32_32x32x16_bf16(afr[tb][s], bfi, ri[tb], 0, 0, 0); }
        }
        const float bav = ba[ch], biv = bi[ch], c8 = -8.f * log1pf(expf(-Lp[ch]));
#pragma unroll
        for (int tb = 0; tb < 2; ++tb)
#pragma unroll
            for (int r = 0; r < 16; ++r) {
                const float xv = xcs[(32 * tb + att::crow(r, hi)) * XROW + 32 * nb + r32];
                const float rr = sigm(ra[tb][r] + bav), ii = sigm(ri[tb][r] + biv), la = c8 * rr;
                const float av = __expf(la), x2 = la + la;
                float pl = 2.48015873e-5f; pl = pl * x2 + 1.98412698e-4f; pl = pl * x2 + 1.38888889e-3f; pl = pl * x2 + 8.33333333e-3f; pl = pl * x2 + 4.16666667e-2f;
                pl = pl * x2 + 1.66666667e-1f; pl = pl * x2 + 0.5f; pl = pl * x2 + 1.0f;
                const float om = (x2 > -0.5f) ? -x2 * pl : 1.f - av * av;
                ra[tb][r] = av; ri[tb][r] = __builtin_amdgcn_sqrtf(om) * (ii * xv);
                if ((r & 3) == 3) __builtin_amdgcn_sched_barrier(0);
            }
        float hc = 0.f, atot = 1.f;
        if (FINAL) {
            const f32x2g* ag = agg + (size_t)b * NCH * 512 + ch; const int cm = c >> 1; int cc = hi ? cm : 0; const int ce = hi ? c : cm; float as = 1.f, hs = 0.f;
            for (; cc + 16 <= ce; cc += 16) { f32x2g g[16];
#pragma unroll
                for (int i = 0; i < 16; ++i) g[i] = ag[(size_t)(cc + i) * 512];
#pragma unroll
                for (int i = 0; i < 16; ++i) { hs = g[i].x * hs + g[i].y; as *= g[i].x; } }
            for (; cc < ce; ++cc) { const f32x2g g = ag[(size_t)cc * 512]; hs = g.x * hs + g.y; as *= g.x; }
            auto sh_ = __builtin_amdgcn_permlane32_swap(__float_as_uint(hs), __float_as_uint(hs), false, false);
            auto sa_ = __builtin_amdgcn_permlane32_swap(__float_as_uint(as), __float_as_uint(as), false, false);
            hc = __uint_as_float(sa_[1]) * __uint_as_float(sh_[0]) + __uint_as_float(sh_[1]);
        }
#pragma unroll
        for (int tb = 0; tb < 2; ++tb)
#pragma unroll
            for (int g4 = 0; g4 < 4; ++g4) {
                float A0[4], A1[4], U0[4], U1[4], k0[4], k1[4];
#pragma unroll
                for (int i = 0; i < 4; ++i) {
                    auto sa = __builtin_amdgcn_permlane32_swap(__float_as_uint(ra[tb][4 * g4 + i]), __float_as_uint(ra[tb][4 * g4 + i]), false, false);
                    auto su = __builtin_amdgcn_permlane32_swap(__float_as_uint(ri[tb][4 * g4 + i]), __float_as_uint(ri[tb][4 * g4 + i]), false, false);
                    A0[i] = __uint_as_float(sa[0]); A1[i] = __uint_as_float(sa[1]); U0[i] = __uint_as_float(su[0]); U1[i] = __uint_as_float(su[1]);
                }
#pragma unroll
                for (int i = 0; i < 4; ++i) { hc = A0[i] * hc + U0[i]; k0[i] = hc; atot *= A0[i]; }
#pragma unroll
                for (int i = 0; i < 4; ++i) { hc = A1[i] * hc + U1[i]; k1[i] = hc; atot *= A1[i]; }
                if (FINAL) {
#pragma unroll
                    for (int i = 0; i < 4; ++i) xcs[(32 * tb + 8 * g4 + 4 * hi + i) * XROW + 32 * nb + r32] = hi ? k1[i] : k0[i];
                }
                __builtin_amdgcn_sched_barrier(0);
            }
        if (!FINAL) { if (hi == 0) agg[((size_t)b * NCH + c) * 512 + ch] = (f32x2g){atot, hc}; }
    }
    if (FINAL) {
        const int c8 = (lane & 7) * 8; const bf16_t* gp = P + (row0 + (lane >> 3)) * DIN + PGR + n * 64 + c8; bf16_t* mp_ = mix + (row0 + (lane >> 3)) * DM + 512 + n * 64 + c8;
        const ALAS float* hp = xcs + (lane >> 3) * XROW + c8;
#pragma unroll 1
        for (int it = 0; it < 8; ++it) {
            const u32x4 raw = *(const u32x4*)gp; const f32x4 h0 = *(const ALAS f32x4*)hp, h1 = *(const ALAS f32x4*)(hp + 4);
            const float gvv[8] = {lo16(raw.x), hi16(raw.x), lo16(raw.y), hi16(raw.y), lo16(raw.z), hi16(raw.z), lo16(raw.w), hi16(raw.w)};
            const float hv[8] = {h0[0], h0[1], h0[2], h0[3], h1[0], h1[1], h1[2], h1[3]}; float y[8];
#pragma unroll
            for (int e = 0; e < 8; ++e) { const float gv = gvv[e], uu = 0.7978845608028654f * (gv + 0.044715f * gv * gv * gv); y[e] = hv[e] * gv * sigm(2.f * uu); }
            *(u32x4*)mp_ = (u32x4){att::cvtpk(y[0], y[1]), att::cvtpk(y[2], y[3]), att::cvtpk(y[4], y[5]), att::cvtpk(y[6], y[7])};
            gp += 8 * DIN; mp_ += 8 * DM; hp += 8 * XROW;
        }
    }
}
}

constexpr int NWAVES = 8;
constexpr size_t MiB = 1u << 20;
constexpr size_t WS_CTL = 0, CTL_ZERO_BYTES = 1 * MiB;
constexpr size_t WS_MOD = 1 * MiB, WS_LAM = 1 * MiB + 256 * 1024;
constexpr size_t WS_W13A = 2 * MiB, WS_W2A = 13 * MiB, WS_W13B = 19 * MiB, WS_W2B = 30 * MiB, WS_WIN = 36 * MiB, WS_WOUT = 41 * MiB, WS_WAT = 43 * MiB, WS_WIT = 43 * MiB + 512 * 1024;
constexpr size_t WS_H = 48 * MiB;
constexpr size_t WS_U = 112 * MiB;
constexpr size_t WS_MIX = 288 * MiB;
constexpr size_t WS_AGG = 352 * MiB;
constexpr size_t WS_NAIVE = 384 * MiB, WS_END = 512 * MiB;
static_assert(WS_W13A + (size_t)2 * DFF * DM * 2 <= WS_W2A && WS_W2A + (size_t)DM * DFF * 2 <= WS_W13B && WS_W13B + (size_t)2 * DFF * DM * 2 <= WS_W2B && WS_W2B + (size_t)DM * DFF * 2 <= WS_WIN
              && WS_WIN + (size_t)DIN * DM * 2 <= WS_WOUT && WS_WOUT + (size_t)DM * DM * 2 <= WS_WAT && WS_H + (size_t)MTOK * DM * 2 <= WS_U && WS_U + (size_t)MTOK * DFF * 2 <= WS_MIX
              && WS_MIX + (size_t)MTOK * DM * 2 <= WS_AGG, "d_ws map");
constexpr int CW_BAR = 4096;
constexpr int RING_OFF = 0, RING_BYTES = 143360;
constexpr int LDSCTL_OFF = RING_BYTES, MISC_OFF = LDSCTL_OFF + 320;
constexpr int LDS_BYTES = 147456;
static_assert(att::L_END <= RING_BYTES && 8 * rg::WAVE_LDS <= RING_BYTES && pg8::STAGE_BYTES <= RING_BYTES && MISC_OFF + 128 <= LDS_BYTES, "LDS map");

#define GAS __attribute__((address_space(1)))
#define LAS __attribute__((address_space(3)))
typedef unsigned short bf16;
typedef unsigned v4u __attribute__((ext_vector_type(4)));
typedef float f32x4 __attribute__((ext_vector_type(4)));
typedef GAS unsigned gu32;
#define RLX_AGENT __ATOMIC_RELAXED, __HIP_MEMORY_SCOPE_AGENT
#define LDS_WAIT() asm volatile("s_waitcnt lgkmcnt(0)" ::: "memory")
#define VM_WAIT() asm volatile("s_waitcnt vmcnt(0)" ::: "memory")
__device__ __forceinline__ unsigned f2bf(float f) { unsigned u = __builtin_bit_cast(unsigned, f); return (u + 0x7fffu + ((u >> 16) & 1u)) >> 16; }
__device__ __forceinline__ unsigned pk2(float lo, float hi) { return f2bf(lo) | (f2bf(hi) << 16); }
__device__ __forceinline__ float wave_sum(float v) {
#pragma unroll
    for (int o = 1; o < 64; o <<= 1) v += __shfl_xor(v, o);
    return v;
}

#define XB_TMO      128
#define XB_XCNT(j)  (256  + 64 * (j))
#define XB_XSUB(j)  (1280 + 64 * (j))
#define XB_XGEN(j)  (2304 + 64 * (j))
#define XB_TOP      3328
#define XB_TOPGEN   3392
#define XCD_BAR_WORDS 3456
#define XB_SPIN_CAP (1u << 18)

__device__ __forceinline__ unsigned xb_ld(unsigned* p)              { return __hip_atomic_load(p, __ATOMIC_RELAXED, __HIP_MEMORY_SCOPE_AGENT); }
__device__ __forceinline__ unsigned xb_add(unsigned* p, unsigned v) { return __hip_atomic_fetch_add(p, v, __ATOMIC_RELAXED, __HIP_MEMORY_SCOPE_AGENT); }
__device__ __forceinline__ unsigned xb_xcc_id() { return (unsigned)__builtin_amdgcn_s_getreg((3 << 11) | 20) & 0xFu; }
#define XB_SPIN(cond, bar) do { unsigned _sp = 0; while (cond) { __builtin_amdgcn_s_sleep(1); \
    if ((++_sp & 255u) == 0u) { if (xb_ld(&(bar)[XB_TMO])) break; if (_sp > XB_SPIN_CAP) { atomicAdd(&(bar)[XB_TMO], 1u); break; } } } } while (0)

struct XcdBarrier {
    unsigned* bar; unsigned x;
    volatile LAS unsigned* st;
};

__device__ __forceinline__ XcdBarrier xcd_barrier_post(unsigned* bar, volatile LAS unsigned* st) {
    XcdBarrier b; b.bar = bar; b.x = xb_xcc_id(); b.st = st;
    if (threadIdx.x == 0) (void)xb_add(&bar[XB_XCNT(b.x)], 1u);
    return b;
}
__device__ __forceinline__ void xcd_barrier_complete(unsigned* bar, unsigned x, unsigned& nloc, unsigned& nx) {
    const unsigned G = gridDim.x * gridDim.y * gridDim.z;
    unsigned sum, cnt, mine, sp = 0u;
    for (;;) {
        sum = 0u; cnt = 0u; mine = 0u;
#pragma unroll
        for (unsigned j = 0; j < 16; ++j) { const unsigned c = xb_ld(&bar[XB_XCNT(j)]); sum += c; cnt += (c > 0u) ? 1u : 0u; mine = (j == x) ? c : mine; }
        if (sum == G) break;
        __builtin_amdgcn_s_sleep(1);
        if ((++sp & 255u) == 0u) { if (xb_ld(&bar[XB_TMO])) break; if (sp > XB_SPIN_CAP) { atomicAdd(&bar[XB_TMO], 1u); break; } }
    }
    nloc = mine > 0u ? mine : 1u; nx = cnt > 0u ? cnt : 1u;
}

__device__ __forceinline__ void xcd_barrier(const XcdBarrier& b) {
    asm volatile("s_waitcnt vmcnt(0)" ::: "memory");
    __syncthreads();
    if (threadIdx.x == 0) {
        unsigned* bar = b.bar;
        __builtin_amdgcn_s_waitcnt(0);
        unsigned nloc = b.st[0], nx = b.st[1];
        if (nloc == 0u) { xcd_barrier_complete(bar, b.x, nloc, nx); b.st[0] = nloc; b.st[1] = nx; }
        const unsigned old = xb_add(&bar[XB_XSUB(b.x)], 1u);
        const unsigned gen = old / nloc;
        if (old + 1u == (gen + 1u) * nloc) {
            __builtin_amdgcn_fence(__ATOMIC_RELEASE, "agent");
            asm volatile("s_waitcnt vmcnt(0)" ::: "memory");
            const unsigned og = xb_add(&bar[XB_TOP], 1u);
            const unsigned tg = og / nx;
            if (og + 1u == (tg + 1u) * nx) xb_add(&bar[XB_TOPGEN], 1u);
            else XB_SPIN(xb_ld(&bar[XB_TOPGEN]) == tg, bar);
            __builtin_amdgcn_fence(__ATOMIC_ACQUIRE, "agent");
            xb_add(&bar[XB_XGEN(b.x)], 1u);
            asm volatile("s_waitcnt vmcnt(0)" ::: "memory");
        } else {
            XB_SPIN(xb_ld(&bar[XB_XGEN(b.x)]) == gen, bar);
            __builtin_amdgcn_fence(__ATOMIC_ACQUIRE, "agent");
            asm volatile("s_waitcnt vmcnt(0)" ::: "memory");
        }
    }
    __syncthreads();
}


__device__ __forceinline__ void transpose_tile(const float* W, int ldw, int k0, int n0, bf16* WT, int ldt, int drow0, LAS float* scr, int lane) {
#pragma unroll 8
    for (int i = 0; i < 32; ++i) { const int kk = 2 * i + (lane >> 5); scr[kk * 33 + (lane & 31)] = W[(size_t)(k0 + kk) * ldw + n0 + (lane & 31)]; }
    LDS_WAIT(); asm volatile("" ::: "memory");
    const int c = lane & 7;
#pragma unroll
    for (int j = 0; j < 4; ++j) { const int n = (lane >> 3) + 8 * j; const LAS float* s = scr + (8 * c) * 33 + n;
        v4u o; o.x = pk2(s[0 * 33], s[1 * 33]); o.y = pk2(s[2 * 33], s[3 * 33]); o.z = pk2(s[4 * 33], s[5 * 33]); o.w = pk2(s[6 * 33], s[7 * 33]);
        *(GAS v4u*)(WT + (size_t)(drow0 + n) * ldt + k0 + 8 * c) = o; }
    LDS_WAIT(); asm volatile("" ::: "memory");
}
struct Args { const float* in[27]; float* out; unsigned char* ws; int ph_lo, ph_hi, li, pad; };

__device__ __forceinline__ void normmod_row(const float* xrow, const float* g, const float* sh, const float* sc, bf16* orow, int lane) {
    const GAS f32x4* xr = (const GAS f32x4*)xrow + lane;
    f32x4 v[4]; float s2 = 0.f;
#pragma unroll
    for (int j = 0; j < 4; ++j) { v[j] = xr[64 * j]; s2 += (v[j].x * v[j].x + v[j].y * v[j].y) + (v[j].z * v[j].z + v[j].w * v[j].w); }
    const float rstd = rsqrtf(wave_sum(s2) * (1.f / DM) + 1e-6f);
    GAS unsigned long long* o8 = (GAS unsigned long long*)orow + lane;
#pragma unroll
    for (int j = 0; j < 4; ++j) { const f32x4 gg = ((const f32x4*)g)[lane + 64 * j], ss = ((const f32x4*)sc)[lane + 64 * j], hh = ((const f32x4*)sh)[lane + 64 * j];
        const f32x4 y = v[j] * rstd * gg * (ss + 1.f) + hh;
        o8[64 * j] = (unsigned long long)pk2(y.x, y.y) | ((unsigned long long)pk2(y.z, y.w) << 32); }
}
__device__ __forceinline__ void finalnorm_row(float* xrow, const float* g, int lane) {
    GAS f32x4* xr = (GAS f32x4*)xrow + lane;
    f32x4 v[4]; float s2 = 0.f;
#pragma unroll
    for (int j = 0; j < 4; ++j) { v[j] = xr[64 * j]; s2 += (v[j].x * v[j].x + v[j].y * v[j].y) + (v[j].z * v[j].z + v[j].w * v[j].w); }
    const float rstd = rsqrtf(wave_sum(s2) * (1.f / DM) + 1e-6f);
#pragma unroll
    for (int j = 0; j < 4; ++j) xr[64 * j] = v[j] * rstd * ((const f32x4*)g)[lane + 64 * j];
}

constexpr int NPH = 13;
#ifndef MK_DUP
#define MK_DUP -1
#endif
#ifndef MK_XBAR
#define MK_XBAR 0
#endif
#define REPS(k) (((k) == MK_DUP) ? 2 : 1)
__global__ void __launch_bounds__(NWAVES * 64, 2) mk_fwd(Args args) {
    extern __shared__ __attribute__((aligned(16))) unsigned char lds[];
    LAS unsigned char* const L = (LAS unsigned char*)lds;
    volatile LAS unsigned* const MISC = (volatile LAS unsigned*)(L + MISC_OFF);
    const int tid0 = threadIdx.x, wave = __builtin_amdgcn_readfirstlane(tid0 >> 6);
#define FRESH_TID() int tid = tid0; asm volatile("" : "+v"(tid)); const int lane = tid & 63
    const int G = gridDim.x; const int bx = blockIdx.x; const int vcu = (G % 8 == 0) ? (bx % 8) * (G / 8) + bx / 8 : bx;
    unsigned char* ws = args.ws;
    gu32* ctl = (gu32*)(ws + WS_CTL);
    const float* x = args.in[0]; const float* cnd = args.in[1]; const float* rel_bias = args.in[2]; const float* ada_w = args.in[3]; const float* ada_b = args.in[4]; const float* norm_g = args.in[5];
    const float* subln_g = args.in[14]; const float* conv_w = args.in[15]; const float* conv_b = args.in[16]; const float* gab = args.in[18]; const float* gib = args.in[20]; const float* lru_L = args.in[21];
    const float* final_g = args.in[26];
    float* out = args.out;
    float* mod = (float*)(ws + WS_MOD); float* lamp = (float*)(ws + WS_LAM);
    bf16* W13A = (bf16*)(ws + WS_W13A); bf16* W2A = (bf16*)(ws + WS_W2A); bf16* W13B = (bf16*)(ws + WS_W13B); bf16* W2B = (bf16*)(ws + WS_W2B);
    bf16* WIN = (bf16*)(ws + WS_WIN); bf16* WOUT = (bf16*)(ws + WS_WOUT); bf16* WAT = (bf16*)(ws + WS_WAT); bf16* WIT = (bf16*)(ws + WS_WIT);
    bf16* H = (bf16*)(ws + WS_H); bf16* U = (bf16*)(ws + WS_U); bf16* P = (bf16*)(ws + WS_U); bf16* MIX = (bf16*)(ws + WS_MIX);
    rg::f32x2g* AGG = (rg::f32x2g*)(ws + WS_AGG);
    for (int u = tid0; u < (LDS_BYTES - LDSCTL_OFF) / 4; u += NWAVES * 64) ((LAS unsigned*)(L + LDSCTL_OFF))[u] = 0u;
    __syncthreads();
    const int lo = args.ph_lo, hi = args.ph_hi;
    const bool multi = (hi - lo) > 1;
    XcdBarrier bar; bar.bar = (unsigned*)(ctl + CW_BAR) + args.li * XCD_BAR_WORDS; bar.x = 0; bar.st = nullptr;
    if (multi) bar = xcd_barrier_post((unsigned*)(ctl + CW_BAR) + args.li * XCD_BAR_WORDS, MISC + 8);
#define IN(k) (lo <= (k) && (k) < hi)
#define SEAM(k) do { if (IN(k) && IN((k) + 1)) xcd_barrier(bar); } while (0)
    const int gw = vcu * NWAVES + wave, NGW = G * NWAVES;

    if (IN(0)) for (int rep_ = 0; rep_ < REPS(0); ++rep_) {
        FRESH_TID();
        {
            LAS float* ca = (LAS float*)(L + RING_OFF); LAS float* red = ca + BATCH * DM;
            for (int i = tid; i < BATCH * DM; i += NWAVES * 64) { const float v = cnd[i]; ca[i] = v / (1.f + __expf(-v)); }
            __syncthreads();
            for (int cbk = bx; cbk < 256; cbk += G) {
#pragma unroll 1
                for (int cc = 0; cc < 3; ++cc) {
                    const int e0 = 36 * cbk + 12 * cc; float acc[4][12];
#pragma unroll
                    for (int b = 0; b < 4; ++b)
#pragma unroll
                        for (int j = 0; j < 12; ++j) acc[b][j] = 0.f;
#pragma unroll
                    for (int i = 0; i < 2; ++i) { const int d = tid + 512 * i; const f32x4* wp = (const f32x4*)(ada_w + (size_t)d * (NMOD * DM) + e0);
                        const f32x4 w0 = wp[0], w1 = wp[1], w2 = wp[2]; const float w[12] = {w0.x, w0.y, w0.z, w0.w, w1.x, w1.y, w1.z, w1.w, w2.x, w2.y, w2.z, w2.w};
#pragma unroll
                        for (int b = 0; b < 4; ++b) { const float cv = ca[b * DM + d];
#pragma unroll
                            for (int j = 0; j < 12; ++j) acc[b][j] += cv * w[j]; } }
#pragma unroll
                    for (int b = 0; b < 4; ++b)
#pragma unroll
                        for (int j = 0; j < 12; ++j) { const float s = wave_sum(acc[b][j]); if (lane == 0) red[wave * 144 + cc * 48 + b * 12 + j] = s; }
                }
                __syncthreads();
                if (tid < 144) { const int cc = tid / 48, b = (tid % 48) / 12, j = tid % 12, e = 36 * cbk + 12 * cc + j; float s = ada_b[e];
#pragma unroll
                    for (int w = 0; w < 8; ++w) s += red[w * 144 + tid];
                    mod[(size_t)b * NMOD * DM + e] = s; }
                __syncthreads();
            }
            if (bx == 0 && wave == 0) { const float s1 = wave_sum(args.in[10][lane] * args.in[11][lane]), s2 = wave_sum(args.in[12][lane] * args.in[13][lane]); if (lane == 0) lamp[0] = expf(s1) - expf(s2) + 0.2f; }
            __syncthreads();
        }
        {
            LAS float* scr = (LAS float*)(L + RING_OFF + wave * 16384);
            constexpr int I_UP = (DM / 64) * (DFF / 32), I_DN = (DFF / 64) * (DM / 32), I_IN = (DM / 64) * (DIN / 32), I_OUT = (DM / 64) * (DM / 32), I_G = 16;
            constexpr int NITEMS = 4 * I_UP + 2 * I_DN + I_IN + I_OUT + 2 * I_G;
            for (int it = gw; it < NITEMS; it += NGW) {
                int r = it;
                if (r < 4 * I_UP) { const int which = r / I_UP; r -= which * I_UP; const int nblk = DFF / 32, kb = r / nblk, nb = r % nblk, n0 = 32 * nb;
                    const float* W = args.in[which == 0 ? 6 : which == 1 ? 7 : which == 2 ? 23 : 24]; bf16* WT = (which < 2) ? W13A : W13B;
                    transpose_tile(W, DFF, 64 * kb, n0, WT, DM, 256 * (n0 >> 7) + (n0 & 127) + ((which & 1) ? 128 : 0), scr, lane); continue; }
                r -= 4 * I_UP;
                if (r < 2 * I_DN) { const int which = r / I_DN; r -= which * I_DN; const int nblk = DM / 32, kb = r / nblk, nb = r % nblk;
                    transpose_tile(args.in[which ? 25 : 8], DM, 64 * kb, 32 * nb, which ? W2B : W2A, DFF, 32 * nb, scr, lane); continue; }
                r -= 2 * I_DN;
                if (r < I_IN) { const int nblk = DIN / 32, kb = r / nblk, nb = r % nblk; transpose_tile(args.in[9], DIN, 64 * kb, 32 * nb, WIN, DM, 32 * nb, scr, lane); continue; }
                r -= I_IN;
                if (r < I_OUT) { const int nblk = DM / 32, kb = r / nblk, nb = r % nblk; transpose_tile(args.in[22], DM, 64 * kb, 32 * nb, WOUT, DM, 32 * nb, scr, lane); continue; }
                r -= I_OUT;
                { const int which = r / I_G; r -= which * I_G; const int n = r >> 1, nb = r & 1;
                  transpose_tile(args.in[which ? 19 : 17] + n * 4096, 64, 0, 32 * nb, (which ? WIT : WAT) + n * 4096, 64, 32 * nb, scr, lane); }
            }
        }
    }
    SEAM(0);
    if (IN(1)) for (int rep_ = 0; rep_ < REPS(1); ++rep_) { FRESH_TID(); for (int m = gw; m < MTOK; m += NGW) { const float* md = mod + (size_t)(m / SEQ) * NMOD * DM; normmod_row(x + (size_t)m * DM, norm_g, md + 0 * DM, md + 1 * DM, H + (size_t)m * DM, lane); } }
    SEAM(1);
    if (IN(2)) for (int rep_ = 0; rep_ < REPS(2); ++rep_) { pg8::Gemm g{H, W13A, MTOK, 2 * DFF, DM}; pg8::StaticOrder S; S.init(MTOK, 2 * DFF, G, bx); pg8::EpiSwiglu E{U};
        pg8::gemm_phase<pg8::EpiSwiglu, pg8::StaticOrder, true, true>(L + RING_OFF, g, S, E); }
    SEAM(2);
    if (IN(3)) for (int rep_ = 0; rep_ < REPS(3); ++rep_) { pg8::Gemm g{U, W2A, MTOK, DM, DFF}; pg8::StaticOrder S; S.init(MTOK, DM, G, bx); pg8::EpiResid E{x, out, mod + 2 * DM, 0.5f};
        pg8::gemm_phase<pg8::EpiResid, pg8::StaticOrder, true, true>(L + RING_OFF, g, S, E); }
    SEAM(3);
    if (IN(4)) for (int rep_ = 0; rep_ < REPS(4); ++rep_) { FRESH_TID(); for (int m = gw; m < MTOK; m += NGW) { const float* md = mod + (size_t)(m / SEQ) * NMOD * DM; normmod_row(out + (size_t)m * DM, norm_g + DM, md + 3 * DM, md + 4 * DM, H + (size_t)m * DM, lane); } }
    SEAM(4);
    if (IN(5)) for (int rep_ = 0; rep_ < REPS(5); ++rep_) { pg8::Gemm g{H, WIN, MTOK, DIN, DM}; pg8::StaticOrder S; S.init(MTOK, DIN, G, bx); pg8::EpiProj E{P};
        pg8::gemm_phase<pg8::EpiProj, pg8::StaticOrder, true, true>(L + RING_OFF, g, S, E); }
    SEAM(5);
    if (IN(6)) for (int rep_ = 0; rep_ < REPS(6); ++rep_) {
#if MK_STAGE >= 3
        for (int i = 0; i < 2; ++i) { const int idx = (i == 0) ? bx : 511 - bx; if (bx < 256) rg::chunk<false>(idx >> 7, idx & 127, P, WAT, WIT, gab, gib, lru_L, conv_w, conv_b, AGG, MIX, (char*)lds + RING_OFF); }
        LDS_WAIT(); __syncthreads();
#endif
#if MK_STAGE >= 2
        { const float lam = lamp[0]; const int bh = (vcu >> 4) & 15, s = vcu & 15;
          if (vcu < 256) for (int i = 0; i < 4; ++i) { const int qb = (i == 0) ? 63 - s : (i == 1) ? 32 + s : (i == 2) ? 31 - s : s;
              att::unit(bh >> 2, bh & 3, qb, P, MIX, rel_bias, lam, subln_g, (char*)lds + RING_OFF); } }
#endif
    }
    SEAM(6);
    if (IN(7)) for (int rep_ = 0; rep_ < REPS(7); ++rep_) {
#if MK_STAGE >= 3
        for (int i = 0; i < 2; ++i) { const int idx = (i == 0) ? bx : 511 - bx; if (bx < 256) rg::chunk<true>(idx >> 7, idx & 127, P, WAT, WIT, gab, gib, lru_L, conv_w, conv_b, AGG, MIX, (char*)lds + RING_OFF); }
        LDS_WAIT(); __syncthreads();
#endif
    }
    SEAM(7);
    if (IN(8)) for (int rep_ = 0; rep_ < REPS(8); ++rep_) { pg8::Gemm g{MIX, WOUT, MTOK, DM, DM}; pg8::StaticOrder S; S.init(MTOK, DM, G, bx); pg8::EpiResid E{out, out, mod + 5 * DM, 1.0f};
        pg8::gemm_phase<pg8::EpiResid, pg8::StaticOrder, true, true>(L + RING_OFF, g, S, E); }
    SEAM(8);
    if (IN(9)) for (int rep_ = 0; rep_ < REPS(9); ++rep_) { FRESH_TID(); for (int m = gw; m < MTOK; m += NGW) { const float* md = mod + (size_t)(m / SEQ) * NMOD * DM; normmod_row(out + (size_t)m * DM, norm_g + 2 * DM, md + 6 * DM, md + 7 * DM, H + (size_t)m * DM, lane); } }
    SEAM(9);
    if (IN(10)) for (int rep_ = 0; rep_ < REPS(10); ++rep_) { pg8::Gemm g{H, W13B, MTOK, 2 * DFF, DM}; pg8::StaticOrder S; S.init(MTOK, 2 * DFF, G, bx); pg8::EpiSwiglu E{U};
        pg8::gemm_phase<pg8::EpiSwiglu, pg8::StaticOrder, true, true>(L + RING_OFF, g, S, E); }
    SEAM(10);
    if (IN(11)) for (int rep_ = 0; rep_ < REPS(11); ++rep_) { pg8::Gemm g{U, W2B, MTOK, DM, DFF}; pg8::StaticOrder S; S.init(MTOK, DM, G, bx); pg8::EpiResid E{out, out, mod + 8 * DM, 0.5f};
        pg8::gemm_phase<pg8::EpiResid, pg8::StaticOrder, true, true>(L + RING_OFF, g, S, E); }
    SEAM(11);
    if (IN(12)) for (int rep_ = 0; rep_ < REPS(12); ++rep_) { FRESH_TID(); for (int m = gw; m < MTOK; m += NGW) finalnorm_row(out + (size_t)m * DM, final_g, lane); }
    for (int xb_ = 0; xb_ < MK_XBAR; ++xb_) xcd_barrier(bar);
#undef IN
#undef SEAM
}

extern "C" void kernel_launch(void* const* d_in, const int* in_sizes, int n_in, void* d_out, int out_size, void* d_ws, size_t ws_size, hipStream_t stream) {
    static int grid = 0;
    if (grid == 0) {
        if (n_in != 27 || in_sizes[0] != MTOK * DM || out_size != MTOK * DM || ws_size < WS_END) { fprintf(stderr, "kernel_launch: unexpected shapes (n_in %d, in0 %d, out %d, ws %zu); nothing launched\n", n_in, n_in > 0 ? in_sizes[0] : -1, out_size, ws_size); grid = -1; return; }
        int dev = 0, cus = 0, per_cu = 0;
        if (hipGetDevice(&dev) != hipSuccess || hipDeviceGetAttribute(&cus, hipDeviceAttributeMultiprocessorCount, dev) != hipSuccess) { grid = -1; return; }
        if (hipFuncSetAttribute((const void*)mk_fwd, hipFuncAttributeMaxDynamicSharedMemorySize, LDS_BYTES) != hipSuccess) { fprintf(stderr, "kernel_launch: hipFuncSetAttribute failed\n"); grid = -1; return; }
        if (hipOccupancyMaxActiveBlocksPerMultiprocessor(&per_cu, (const void*)mk_fwd, NWAVES * 64, LDS_BYTES) != hipSuccess || per_cu < 1) { fprintf(stderr, "kernel_launch: occupancy query says %d blocks per CU\n", per_cu); }
        (void)hipGetLastError();
        grid = cus;
        if (grid != 256) fprintf(stderr, "kernel_launch: %d CUs (built for 256)\n", grid);
    }
    if (grid < 0) return;
    (void)hipMemsetAsync((char*)d_ws + WS_CTL, 0, CTL_ZERO_BYTES, stream);
    Args a{};
    for (int i = 0; i < 27; ++i) a.in[i] = (const float*)d_in[i];
    a.out = (float*)d_out; a.ws = (unsigned char*)d_ws;
#define MK_LAUNCH(lo_, hi_, li_) do { a.ph_lo = (lo_); a.ph_hi = (hi_); a.li = (li_); hipLaunchKernelGGL(mk_fwd, dim3(grid), dim3(NWAVES * 64), LDS_BYTES, stream, a); } while (0)
#if MK_STAGE >= 4
    MK_LAUNCH(0, NPH, 0);
#elif MK_STAGE == 3
    for (int p = 0; p < NPH; ++p) MK_LAUNCH(p, p + 1, 0);
#else
    {
        using namespace nv;
        unsigned char* ws = (unsigned char*)d_ws;
        const bf16_t* P = (const bf16_t*)(ws + WS_U); bf16_t* mix = (bf16_t*)(ws + WS_MIX); const float* lam = (const float*)(ws + WS_LAM);
        float* Opart = (float*)(ws + WS_NAIVE); float* xc = (float*)(ws + WS_NAIVE); float* ub = (float*)(ws + WS_NAIVE + 64 * MiB); float* ab = (float*)(ws + WS_H);
#if MK_STAGE == 1
        MK_LAUNCH(0, 6, 0);
        k_attn<<<dim3(SEQ / 256, 8, BATCH), 256, 0, stream>>>(P, (const float*)d_in[2], Opart);
        k_attn_combine<<<MTOK * 4 / 4, 256, 0, stream>>>(Opart, lam, (const float*)d_in[14], mix);
#else
        MK_LAUNCH(0, 7, 0);
#endif
        k_conv<<<MTOK * 512 / 256, 256, 0, stream>>>(P, (const float*)d_in[15], (const float*)d_in[16], xc);
        k_gates<<<MTOK * 512 / 256, 256, 0, stream>>>(xc, (const float*)d_in[17], (const float*)d_in[18], (const float*)d_in[19], (const float*)d_in[20], (const float*)d_in[21], ab, ub);
        k_scan<<<BATCH * 512 / 64, 64, 0, stream>>>(ab, ub, P, mix);
        MK_LAUNCH(8, NPH, 1);
    }
#endif
}
```
